# Optimizing an MI355X kernel written in HIP

```python
import math
import jax, jax.numpy as jnp
from jax import lax
import numpy as np

D_MODEL = 1024
BATCH = 16
SEQ = 2048
DEPTH = 2

HEAD_DIM = 64
SSM_WIDTH = 3 * D_MODEL // 8
FFT_WIDTH = D_MODEL // 4
ATT_WIDTH = D_MODEL - SSM_WIDTH - FFT_WIDTH
SSM_GROUP = 16
SSM_GROUPS = SSM_WIDTH // SSM_GROUP
SSM_STATE = 64
FFT_HEADS = FFT_WIDTH // HEAD_DIM
N_Q_HEADS = ATT_WIDTH // HEAD_DIM
N_KV_HEADS = 2
GQA_GROUP = N_Q_HEADS // N_KV_HEADS
KV_WIDTH = N_KV_HEADS * HEAD_DIM
IN_WIDTH = SSM_WIDTH + FFT_WIDTH + ATT_WIDTH + 2 * KV_WIDTH
WINDOW = 128
BLOCK = 128
KV_SPAN = 3 * BLOCK
D_FF = ((8 * D_MODEL // 3 + 255) // 256) * 256
DT_MIN = 1e-3
DT_MAX = 1e-1
RMS_EPS = 1e-6
NEG_INF = -1e30

kernel_name = 'hybrid_s5_fnet_swa_convffn_encoder'


def rms_norm(x, gain):
    xf = x.astype(jnp.float32)
    y = xf * lax.rsqrt(jnp.mean(xf * xf, axis=-1, keepdims=True) + RMS_EPS)
    return (y * gain.astype(jnp.float32)).astype(x.dtype)


def _scan_combine(left, right):
    a_l, h_l = left
    a_r, h_r = right
    return a_l * a_r, a_r * h_l + h_r


def s5_mixer(u, lam_re, lam_im, log_dt, b_re, b_im, c_re, c_im, d_skip, w_glu):
    bsz, seq, _ = u.shape
    f32 = jnp.float32
    uf = u.astype(f32).reshape(bsz, seq, SSM_GROUPS, SSM_GROUP)
    lam = lax.complex(lam_re.astype(f32), lam_im.astype(f32))
    dt = jnp.exp(log_dt.astype(f32))[..., None]
    lam_bar = jnp.exp(lam * dt)
    b = lax.complex(b_re.astype(f32), b_im.astype(f32))
    b_bar = ((lam_bar - 1.0) / lam)[..., None] * b
    states = []
    for d, rev in ((0, False), (1, True)):
        bu = lax.complex(jnp.einsum('bsgc,gpc->bsgp', uf, b_bar[d].real),
                         jnp.einsum('bsgc,gpc->bsgp', uf, b_bar[d].imag))
        a = jnp.broadcast_to(lam_bar[d], bu.shape)
        _, h_dir = lax.associative_scan(_scan_combine, (a, bu), reverse=rev, axis=1)
        states.append(h_dir)
    h = states[0] + states[1]
    y = (jnp.einsum('bsgp,gcp->bsgc', h.real, c_re.astype(f32))
         - jnp.einsum('bsgp,gcp->bsgc', h.imag, c_im.astype(f32)))
    y = y.reshape(bsz, seq, SSM_WIDTH) + d_skip.astype(f32) * u.astype(f32)
    y = jax.nn.gelu(y).astype(u.dtype)
    return y * jax.nn.sigmoid(y @ w_glu)


def fourier_mixer(f, w_fft):
    bsz, seq, _ = f.shape
    ff = f.astype(jnp.float32).reshape(bsz, seq, FFT_HEADS, HEAD_DIM)
    mixed = jnp.fft.fft2(ff, axes=(1, 3), norm='ortho').real.astype(f.dtype)
    return jnp.einsum('bshd,hde->bshe', mixed, w_fft).reshape(bsz, seq, FFT_WIDTH)


def window_attention(q, k, v, sink):
    bsz, seq, _ = q.shape
    nblk = seq // BLOCK
    qb = (q * HEAD_DIM ** -0.5).reshape(bsz, nblk, BLOCK, N_KV_HEADS, GQA_GROUP, HEAD_DIM)

    def band(t):
        t = t.reshape(bsz, seq, N_KV_HEADS, HEAD_DIM)
        t = jnp.pad(t, ((0, 0), (BLOCK, BLOCK), (0, 0), (0, 0)))
        t = t.reshape(bsz, nblk + 2, BLOCK, N_KV_HEADS, HEAD_DIM)
        return jnp.concatenate([t[:, :-2], t[:, 1:-1], t[:, 2:]], axis=2)

    kb, vb = band(k), band(v)
    qi = jnp.arange(BLOCK)[:, None]
    kj = jnp.arange(KV_SPAN)[None, :]
    dist = jnp.abs(qi + BLOCK - kj)
    key_pos = jnp.arange(nblk)[:, None] * BLOCK - BLOCK + kj
    valid = (dist <= WINDOW)[None] & ((key_pos >= 0) & (key_pos < seq))[:, None, :]
    slopes = jnp.exp2(-8.0 * jnp.arange(1, N_Q_HEADS + 1, dtype=jnp.float32) / N_Q_HEADS)
    slopes = slopes.reshape(N_KV_HEADS, GQA_GROUP)
    bias = -slopes[:, :, None, None] * dist.astype(jnp.float32)
    scores = jnp.einsum('bnqkgd,bnskd->bnkgqs', qb, kb).astype(jnp.float32) + bias
    scores = jnp.where(valid[None, :, None, None], scores, NEG_INF)
    sink_l = sink.astype(jnp.float32).reshape(1, 1, N_KV_HEADS, GQA_GROUP, 1, 1)
    m = jnp.maximum(jnp.max(scores, axis=-1, keepdims=True), sink_l)
    p = jnp.exp(scores - m)
    p = p / (jnp.sum(p, axis=-1, keepdims=True) + jnp.exp(sink_l - m))
    out = jnp.einsum('bnkgqs,bnskd->bnqkgd', p.astype(v.dtype), vb)
    return out.reshape(bsz, seq, ATT_WIDTH)


def dwconv3(h, w, b):
    hp = jnp.pad(h, ((0, 0), (1, 1), (0, 0)))
    return hp[:, :-2] * w[0] + hp[:, 1:-1] * w[1] + hp[:, 2:] * w[2] + b


def setup_inputs(seed: int = 0) -> dict:
    key = jax.random.key(seed)
    ks = iter(jax.random.split(key, 32))
    nrm = lambda shape, scale: scale * jax.random.normal(next(ks), shape, jnp.float32)
    L, D, G, P = DEPTH, D_MODEL, SSM_GROUPS, SSM_STATE
    lam_im_base = jnp.pi * jnp.arange(P, dtype=jnp.float32)
    return {
        'x': nrm((BATCH, SEQ, D), 1.0),
        'c': nrm((BATCH, D), 1.0),
        'w_ada': nrm((L, D, 6 * D), 0.5 * D ** -0.5),
        'b_ada': nrm((L, 6 * D), 0.01),
        'g_pre_mix': 1.0 + nrm((L, D), 0.05),
        'g_post_mix': 1.0 + nrm((L, D), 0.05),
        'g_pre_ffn': 1.0 + nrm((L, D), 0.05),
        'g_post_ffn': 1.0 + nrm((L, D), 0.05),
        'w_in': nrm((L, D, IN_WIDTH), D ** -0.5),
        'lam_re': -0.5 + nrm((L, 2, G, P), 0.01),
        'lam_im': lam_im_base + nrm((L, 2, G, P), 0.01),
        'log_dt': jax.random.uniform(next(ks), (L, 2, G), jnp.float32,
                                     minval=math.log(DT_MIN), maxval=math.log(DT_MAX)),
        'b_re': nrm((L, 2, G, P, SSM_GROUP), (2 * SSM_GROUP) ** -0.5),
        'b_im': nrm((L, 2, G, P, SSM_GROUP), (2 * SSM_GROUP) ** -0.5),
        'c_re': nrm((L, G, SSM_GROUP, P), (2 * P) ** -0.5),
        'c_im': nrm((L, G, SSM_GROUP, P), (2 * P) ** -0.5),
        'd_skip': nrm((L, SSM_WIDTH), 1.0),
        'w_glu': nrm((L, SSM_WIDTH, SSM_WIDTH), SSM_WIDTH ** -0.5),
        'w_fft': nrm((L, FFT_HEADS, HEAD_DIM, HEAD_DIM), HEAD_DIM ** -0.5),
        'sink': nrm((L, N_Q_HEADS), 1.0),
        'w_out': nrm((L, D, D), D ** -0.5),
        'w_up': nrm((L, D, 2 * D_FF), D ** -0.5),
        'conv_w': nrm((L, 3, 2 * D_FF), 3 ** -0.5),
        'conv_b': nrm((L, 2 * D_FF), 0.01),
        'w_down': nrm((L, D_FF, D), D_FF ** -0.5),
    }


def reference(x, c, w_ada, b_ada, g_pre_mix, g_post_mix, g_pre_ffn, g_post_ffn, w_in,
              lam_re, lam_im, log_dt, b_re, b_im, c_re, c_im, d_skip, w_glu, w_fft, sink,
              w_out, w_up, conv_w, conv_b, w_down):
    splits = [SSM_WIDTH, SSM_WIDTH + FFT_WIDTH, SSM_WIDTH + FFT_WIDTH + ATT_WIDTH,
              SSM_WIDTH + FFT_WIDTH + ATT_WIDTH + KV_WIDTH]
    for l in range(DEPTH):
        mod = (c @ w_ada[l] + b_ada[l])[:, None, :]
        sh_m, sc_m, gt_m, sh_f, sc_f, gt_f = jnp.split(mod, 6, axis=-1)

        h = rms_norm(x, g_pre_mix[l]) * (1.0 + sc_m) + sh_m
        z = h @ w_in[l]
        u, f, q, k, v = jnp.split(z, splits, axis=-1)
        y_ssm = s5_mixer(u, lam_re[l], lam_im[l], log_dt[l], b_re[l], b_im[l],
                         c_re[l], c_im[l], d_skip[l], w_glu[l])
        y_fft = fourier_mixer(f, w_fft[l])
        y_att = window_attention(q, k, v, sink[l])
        y = jnp.concatenate([y_ssm.astype(x.dtype), y_fft.astype(x.dtype), y_att.astype(x.dtype)], axis=-1) @ w_out[l]
        x = x + gt_m * rms_norm(y, g_post_mix[l])

        h = rms_norm(x, g_pre_ffn[l]) * (1.0 + sc_f) + sh_f
        up = dwconv3(h @ w_up[l], conv_w[l], conv_b[l])
        gate, val = jnp.split(up, 2, axis=-1)
        y = (jax.nn.gelu(gate) * val) @ w_down[l]
        x = x + gt_f * rms_norm(y, g_post_ffn[l])
    return x
```

```cpp
#include <hip/hip_runtime.h>
#include <hip/hip_cooperative_groups.h>
#include <cstdio>
namespace cg = cooperative_groups;

#define DI __device__ __forceinline__
#define LAS __attribute__((address_space(3)))
typedef unsigned short bf16_t;
typedef short bf16x8 __attribute__((ext_vector_type(8)));
typedef short s16x4 __attribute__((ext_vector_type(4)));
typedef float f32x2 __attribute__((ext_vector_type(2)));
typedef float f32x4 __attribute__((ext_vector_type(4)));
typedef float f32x16 __attribute__((ext_vector_type(16)));
typedef unsigned u32x2 __attribute__((ext_vector_type(2)));
typedef unsigned u32x4 __attribute__((ext_vector_type(4)));
typedef __bf16 nbf16x2 __attribute__((ext_vector_type(2)));

constexpr int MTOK = 32768, DM = 1024, SEQ = 2048, NB = 16, NL = 2, DFF = 2816;
constexpr int BM = 256, BK = 64, HALF = 128, HTB = HALF * BK * 2, STAGE_BYTES = 8 * HTB;
constexpr int LDS_BYTES = 155648;
constexpr int NTHREADS = 512;

constexpr size_t O_WIN = 0;
constexpr size_t O_WPQ = O_WIN + 1024ull * 1024 * 2;
constexpr size_t O_WGLU = O_WPQ + 512ull * 1024 * 2;
constexpr size_t O_WOUT = O_WGLU + 512ull * 384 * 2;
constexpr size_t O_WUP = O_WOUT + 1024ull * 1024 * 2;
constexpr size_t O_WDN = O_WUP + 5632ull * 1024 * 2;
constexpr size_t O_SA = O_WDN + 1024ull * 2816 * 2;
constexpr size_t O_SB = O_SA + 2ull * 24 * 2 * 64 * 4;
constexpr size_t O_SC = O_SB + 2ull * 24 * 4 * 64 * 8 * 2;
constexpr size_t O_CB = O_SC + 2ull * 24 * 8 * 64 * 8 * 2;
constexpr size_t LAYER_W = O_CB + 2ull * 24 * 64 * 8 * 2;
constexpr size_t O_DFT = 2 * LAYER_W;
constexpr size_t O_MOD = O_DFT + 2048ull * 4096 * 2;
constexpr size_t O_CTR = O_MOD + 2ull * 16 * 6144 * 4;
constexpr size_t O_H = O_CTR + 16384;
constexpr size_t O_Y = O_H + (size_t)MTOK * 1024 * 2;
constexpr size_t O_RSS = O_Y + (size_t)MTOK * 1024 * 2;
constexpr size_t O_Z = O_RSS + (size_t)MTOK * 16 * 4;
constexpr size_t O_PQT = O_Z + (size_t)MTOK * 1024 * 2;
constexpr size_t O_YPRE = O_PQT + 512ull * MTOK * 2;
constexpr size_t O_YCAT = O_YPRE + (size_t)MTOK * 384 * 2;
constexpr size_t O_EDGE = O_YCAT + (size_t)MTOK * 1024 * 2;
constexpr size_t O_UT = O_EDGE + 512ull * 4 * 5632 * 2;
constexpr size_t O_XB = O_UT + (size_t)MTOK * 384 * 2;
constexpr size_t O_END = O_XB + (size_t)MTOK * 1024 * 2;
constexpr size_t O_AB = O_H + 2ull * MTOK * 384 * 4;
static_assert(O_AB + 2ull * 16 * 1024 * 256 * 4 <= O_H + 2ull * MTOK * 1024 * 2, "ab alias");
constexpr size_t O_YFB = O_H;
constexpr size_t O_ACT = O_Z;
static_assert(2ull * MTOK * 384 * 4 <= 2ull * MTOK * 1024 * 2, "yfb alias");
static_assert((size_t)MTOK * 2816 * 2 <= O_EDGE - O_Z, "act alias");

struct Params {
    const float* in[25];
    float* out;
    unsigned char* ws;
    int ph_lo, ph_hi;
};
enum { I_X = 0, I_C, I_WADA, I_BADA, I_GPREMIX, I_GPOSTMIX, I_GPREFFN, I_GPOSTFFN, I_WIN, I_LAMRE, I_LAMIM, I_LOGDT, I_BRE, I_BIM, I_CRE, I_CIM,
       I_DSKIP, I_WGLU, I_WFFT, I_SINK, I_WOUT, I_WUP, I_CONVW, I_CONVB, I_WDOWN };

DI unsigned pk_bf16(float lo, float hi) {
    f32x2 v = {lo, hi};
    nbf16x2 b = __builtin_convertvector(v, nbf16x2);
    return __builtin_bit_cast(unsigned, b);
}
DI float bf_lo(unsigned w) { return __uint_as_float(w << 16); }
DI float bf_hi(unsigned w) { return __uint_as_float(w & 0xffff0000u); }
DI float bf2f(bf16_t b) { return __uint_as_float(((unsigned)b) << 16); }
DI bf16_t f2bf(float f) { return (bf16_t)(pk_bf16(f, 0.f) & 0xffffu); }
DI float gelu_tanh(float x) {
    float t = x * (1.0f + 0.044715f * x * x);
    float e = __builtin_amdgcn_exp2f(-2.302208198f * t);
    return x * __builtin_amdgcn_rcpf(1.0f + e);
}
DI float sigmoidf_(float x) { return __builtin_amdgcn_rcpf(1.0f + __builtin_amdgcn_exp2f(-1.442695041f * x)); }
DI bf16x8 pack8(float a0, float a1, float a2, float a3, float a4, float a5, float a6, float a7) {
    u32x4 w; w.x = pk_bf16(a0, a1); w.y = pk_bf16(a2, a3); w.z = pk_bf16(a4, a5); w.w = pk_bf16(a6, a7);
    return __builtin_bit_cast(bf16x8, w);
}
DI int otid() { int t = threadIdx.x; asm volatile("" : "+v"(t)); return t; }
DI int obid() { int b = blockIdx.x; asm volatile("" : "+s"(b)); return b; }
DI float bperm(float v, int srclane) { return __int_as_float(__builtin_amdgcn_ds_bpermute(srclane << 2, __float_as_int(v))); }
#define MFMA32(a, b, c) __builtin_amdgcn_mfma_f32_32x32x16_bf16((a), (b), (c), 0, 0, 0)

DI int lds_byte(int r, int c) { const int st = (r >> 4) * 2 + (c >> 5), rr = r & 15, cc = c & 31, ob = rr * 64 + cc * 2; return st * 1024 + (ob ^ (((ob >> 9) & 1) << 5)); }
DI void stage_rc(int b, int& R, int& C) { const int st = b / 1024, sb = b % 1024, swz = sb ^ (((sb >> 9) & 1) << 5); R = (st >> 1) * 16 + swz / 64; C = (st & 1) * 32 + (swz % 64) / 2; }
DI int perm32(int rho) { const int n = rho >> 4, i = rho & 15; return 8 * (i >> 2) + 4 * n + (i & 3); }

struct Unit { const char* A; const char* B; char* C; int ldc; int pm, pn; int kind; };
struct TileMap {
    int nM, nN, nwg;
    DI void init(int nM_, int nN_) { nM = nM_; nN = nN_; nwg = nM_ * nN_; }
    DI void get(int L, int& pm, int& pn) const {
        int wgid = L; { const int q = nwg / 8, r = nwg % 8, xcd = wgid % 8, off = wgid / 8; wgid = (xcd < r ? xcd * (q + 1) : r * (q + 1) + (xcd - r) * q) + off; }
        const int nig = 8 * nN, gid = wgid / nig, fm = gid * 8, gsz = (nM - fm) < 8 ? (nM - fm) : 8;
        pm = fm + ((wgid % nig) % gsz); pn = (wgid % nig) / gsz;
    }
};

template <class Epi, class Sched>
DI void gemm_phase(LAS unsigned char* lds, const int K, const int lda, const int ldb, const int jt, const long jumpB, Sched& S, const Epi& E) {
    const int tid = otid(), wid = __builtin_amdgcn_readfirstlane(tid >> 6), lane = tid & 63, wr = wid >> 2, wc = wid & 3, fr = lane & 15, fq = lane >> 4;
    const int nt = K / BK;
    unsigned voffA[2], voffB[2];
#pragma unroll
    for (int i = 0; i < 2; ++i) { int R, C; stage_rc(tid * 16 + i * 8192, R, C); const int Rb = (R >> 5) * 64 + perm32(R & 31);
        const int Ra = Epi::APERM ? ((R & ~63) + 4 * (R & 15) + ((R >> 4) & 3)) : R;
        voffA[i] = (unsigned)(Ra * lda + C) * 2u; voffB[i] = (unsigned)(Rb * ldb + C) * 2u; }
    const size_t kstep = (size_t)(BK * 2);
    const size_t hstepA = (size_t)HALF * lda * 2, hstepB = (size_t)32 * ldb * 2;
    const unsigned ldsw = (unsigned)wid * 1024u;
    const int aoff = lds_byte(wr * 64 + fr, fq * 8), boff = lds_byte(wc * 32 + fr, fq * 8);
#define PG8_SA(b, h) (((b) * 2 + (h)) * HTB)
#define PG8_SB(b, h) ((4 + (b) * 2 + (h)) * HTB)
#define PG8_STAGE(bufoff, gbase, voff) do { _Pragma("unroll") for (int _i = 0; _i < 2; ++_i) \
        __builtin_amdgcn_global_load_lds((const unsigned*)((const char*)(gbase) + (voff)[_i]), (LAS unsigned*)(lds + (bufoff) + ldsw + _i * 8192), 16, 0, 0); } while (0)
#define PG8_LDA(dst, b, h) do { _Pragma("unroll") for (int m = 0; m < 4; ++m) _Pragma("unroll") for (int k = 0; k < 2; ++k) dst[m][k] = *(const LAS bf16x8*)(lds + PG8_SA(b, h) + aoff + m * 2048 + k * 1024); } while (0)
#define PG8_LDB(dst, b, h) do { _Pragma("unroll") for (int n = 0; n < 2; ++n) _Pragma("unroll") for (int k = 0; k < 2; ++k) dst[n][k] = *(const LAS bf16x8*)(lds + PG8_SB(b, h) + boff + n * 2048 + k * 1024); } while (0)
#define PG8_MMA(ai, bj, At, Bt) do { __builtin_amdgcn_s_setprio(1); _Pragma("unroll") for (int m = 0; m < 4; ++m) _Pragma("unroll") for (int n = 0; n < 2; ++n) _Pragma("unroll") for (int k = 0; k < 2; ++k) \
        acc[ai][bj][m][n] = __builtin_amdgcn_mfma_f32_16x16x32_bf16(Bt[n][k], At[m][k], acc[ai][bj][m][n], 0, 0, 0); __builtin_amdgcn_s_setprio(0); } while (0)
#define PG8_WAIT_V(n) asm volatile("s_waitcnt vmcnt(" #n ")" ::: "memory")
#define PG8_WAIT_L(n) asm volatile("s_waitcnt lgkmcnt(" #n ")" ::: "memory")
#define PG8_BAR __builtin_amdgcn_s_barrier()
#define PG8_SCHED __builtin_amdgcn_sched_barrier(0)
    Unit cur, nxt; int ui = 0;
    if (!S.next(0, cur)) return;
    f32x4 acc[2][2][4][2];
#pragma unroll
    for (int a = 0; a < 2; ++a)
#pragma unroll
        for (int b = 0; b < 2; ++b)
#pragma unroll
            for (int m = 0; m < 4; ++m)
#pragma unroll
                for (int n = 0; n < 2; ++n) acc[a][b][m][n] = (f32x4){0.f, 0.f, 0.f, 0.f};
    bf16x8 At[4][2], B0[2][2], B1[2][2];
    const char* cA = cur.A; const char* cB = cur.B;
    E.begin(cur, lds);
    PG8_STAGE(PG8_SB(0, 0), cB, voffB); PG8_STAGE(PG8_SA(0, 0), cA, voffA); PG8_STAGE(PG8_SB(0, 1), cB + hstepB, voffB); PG8_STAGE(PG8_SA(0, 1), cA + hstepA, voffA);
    if (wr == 1) PG8_BAR;
    PG8_WAIT_V(4); PG8_BAR;
    PG8_STAGE(PG8_SB(1, 0), cB + kstep, voffB); PG8_STAGE(PG8_SA(1, 0), cA + kstep, voffA); PG8_STAGE(PG8_SB(1, 1), cB + hstepB + kstep, voffB);
    PG8_WAIT_V(6); PG8_BAR;
    for (;;) {
        const bool has_next = S.next(ui + 1, nxt);
        const char* nA = has_next ? nxt.A : cA; const char* nB = has_next ? nxt.B : cB;
#pragma unroll 1
        for (int t = 0; t < nt; t += 2) {
            const bool last = (t == nt - 2);
            const char* a1 = cA + (size_t)(t + 1) * kstep;
            const char* a2 = last ? nA : cA + (size_t)(t + 2) * kstep;
            const char* b2 = last ? nB : cB + (size_t)(t + 2) * kstep + ((t + 2) >= jt ? jumpB : 0);
            const char* a3 = a2 + kstep; const char* b3 = b2 + kstep;
            PG8_LDB(B0, 0, 0); PG8_SCHED; PG8_LDA(At, 0, 0); PG8_STAGE(PG8_SA(1, 1), a1 + hstepA, voffA);
            PG8_WAIT_L(8); PG8_BAR; PG8_WAIT_L(0); PG8_MMA(0, 0, At, B0); PG8_BAR; PG8_SCHED;
            PG8_LDB(B1, 0, 1); PG8_STAGE(PG8_SB(0, 0), b2, voffB);
            PG8_BAR; PG8_WAIT_L(0); PG8_MMA(0, 1, At, B1); PG8_BAR;
            PG8_LDA(At, 0, 1); PG8_STAGE(PG8_SA(0, 0), a2, voffA);
            PG8_BAR; PG8_WAIT_L(0); PG8_MMA(1, 0, At, B0); PG8_BAR; PG8_SCHED;
            PG8_STAGE(PG8_SB(0, 1), b2 + hstepB, voffB);
            PG8_WAIT_V(6); PG8_BAR; PG8_MMA(1, 1, At, B1); PG8_BAR;
            PG8_LDB(B0, 1, 0); PG8_SCHED; PG8_LDA(At, 1, 0); PG8_STAGE(PG8_SA(0, 1), a2 + hstepA, voffA);
            PG8_WAIT_L(8); PG8_BAR; PG8_WAIT_L(0); PG8_MMA(0, 0, At, B0); PG8_BAR; PG8_SCHED;
            PG8_LDB(B1, 1, 1); PG8_STAGE(PG8_SB(1, 0), b3, voffB);
            PG8_BAR; PG8_WAIT_L(0); PG8_MMA(0, 1, At, B1); PG8_BAR;
            PG8_LDA(At, 1, 1); PG8_STAGE(PG8_SA(1, 0), a3, voffA);
            PG8_BAR; PG8_WAIT_L(0); PG8_MMA(1, 0, At, B0); PG8_BAR; PG8_SCHED;
            PG8_STAGE(PG8_SB(1, 1), b3 + hstepB, voffB);
            PG8_WAIT_V(6); PG8_BAR; PG8_MMA(1, 1, At, B1); PG8_BAR;
        }
        E(acc, cur, nxt, has_next, ui, lds, wr, wc);
        if (!has_next) break;
#pragma unroll
        for (int a = 0; a < 2; ++a)
#pragma unroll
            for (int b = 0; b < 2; ++b)
#pragma unroll
                for (int m = 0; m < 4; ++m)
#pragma unroll
                    for (int n = 0; n < 2; ++n) acc[a][b][m][n] = (f32x4){0.f, 0.f, 0.f, 0.f};
        cur = nxt; cA = nA; cB = nB; ++ui;
    }
    PG8_WAIT_V(0);
    if (wr == 0) PG8_BAR;
    PG8_BAR;
#undef PG8_SA
#undef PG8_SB
#undef PG8_STAGE
#undef PG8_LDA
#undef PG8_LDB
#undef PG8_MMA
#undef PG8_WAIT_V
#undef PG8_WAIT_L
#undef PG8_BAR
#undef PG8_SCHED
}

typedef f32x4 Acc[2][2][4][2];
DI int opaque_lane() { int l; asm volatile("v_mbcnt_lo_u32_b32 %0, -1, 0\n\tv_mbcnt_hi_u32_b32 %0, -1, %0" : "=v"(l)); return l; }
struct EpiBf16 {
    static constexpr bool APERM = false;
    DI void begin(const Unit&, LAS unsigned char*) const {}
    DI void operator()(Acc& acc, const Unit& u, const Unit&, bool, int, LAS unsigned char*, int wr, int wc) const {
        const int lane_ = opaque_lane(), fr = lane_ & 15, fq = lane_ >> 4;
        bf16_t* base = (bf16_t*)u.C + (size_t)(wr * 64 + fr) * u.ldc + wc * 64 + 8 * fq;
#pragma unroll
        for (int ai = 0; ai < 2; ++ai)
#pragma unroll
            for (int m = 0; m < 4; ++m) { bf16_t* rowp = base + (size_t)(ai * HALF + m * 16) * u.ldc;
#pragma unroll
                for (int bj = 0; bj < 2; ++bj) { const f32x4 v0 = acc[ai][bj][m][0], v1 = acc[ai][bj][m][1];
                    u32x4 w; w.x = pk_bf16(v0[0], v0[1]); w.y = pk_bf16(v0[2], v0[3]); w.z = pk_bf16(v1[0], v1[1]); w.w = pk_bf16(v1[2], v1[3]);
                    __builtin_nontemporal_store(w, (u32x4*)(rowp + bj * 32)); } }
    }
};
struct EpiInproj {
    static constexpr bool APERM = false;
    bf16_t* ut;
    DI void begin(const Unit&, LAS unsigned char*) const {}
    DI void operator()(Acc& acc, const Unit& u, const Unit&, bool, int, LAS unsigned char*, int wr, int wc) const {
        const int lane_ = opaque_lane(), fr = lane_ & 15, fq = lane_ >> 4;
        bf16_t* base = (bf16_t*)u.C + (size_t)(wr * 64 + fr) * u.ldc + wc * 64 + 8 * fq;
#pragma unroll
        for (int ai = 0; ai < 2; ++ai)
#pragma unroll
            for (int m = 0; m < 4; ++m) { bf16_t* rowp = base + (size_t)(ai * HALF + m * 16) * u.ldc;
#pragma unroll
                for (int bj = 0; bj < 2; ++bj) { const f32x4 v0 = acc[ai][bj][m][0], v1 = acc[ai][bj][m][1];
                    u32x4 w; w.x = pk_bf16(v0[0], v0[1]); w.y = pk_bf16(v0[2], v0[3]); w.z = pk_bf16(v1[0], v1[1]); w.w = pk_bf16(v1[2], v1[3]);
                    if (u.kind == 0 && u.pn * BM + wc * 64 < 384) {
                        const int col = u.pn * BM + wc * 64 + bj * 32 + 8 * fq, t = u.pm * BM + ai * HALF + wr * 64 + m * 16 + fr;
                        const unsigned o = (unsigned)((((((t >> 11) * 24 + (col >> 4)) * 64 + (t & 63)) * 32 + ((t >> 6) & 31)) * 16) + (col & 8));
                        *(u32x4*)(ut + o) = w;
                    } else __builtin_nontemporal_store(w, (u32x4*)(rowp + bj * 32)); } }
    }
};
struct EpiF32 {
    static constexpr bool APERM = false;
    DI void begin(const Unit&, LAS unsigned char*) const {}
    DI void operator()(Acc& acc, const Unit& u, const Unit&, bool, int, LAS unsigned char*, int wr, int wc) const {
        const int lane_ = opaque_lane(), fr = lane_ & 15, fq = lane_ >> 4;
        float* base = (float*)u.C + (size_t)(wr * 64 + fr) * u.ldc + wc * 64 + 8 * fq;
#pragma unroll
        for (int ai = 0; ai < 2; ++ai)
#pragma unroll
            for (int m = 0; m < 4; ++m) { float* rowp = base + (size_t)(ai * HALF + m * 16) * u.ldc;
#pragma unroll
                for (int bj = 0; bj < 2; ++bj) { *(f32x4*)(rowp + bj * 32) = acc[ai][bj][m][0]; *(f32x4*)(rowp + bj * 32 + 4) = acc[ai][bj][m][1]; } }
    }
};
struct EpiGlu {
    static constexpr bool APERM = false;
    const bf16_t* ypre; bf16_t* ycat;
    DI void begin(const Unit&, LAS unsigned char*) const {}
    DI void operator()(Acc& acc, const Unit& u, const Unit&, bool, int, LAS unsigned char*, int wr, int wc) const {
#pragma unroll
        for (int ai = 0; ai < 2; ++ai)
#pragma unroll
            for (int bj = 0; bj < 2; ++bj)
#pragma unroll
                for (int m = 0; m < 4; ++m)
#pragma unroll
                    for (int n = 0; n < 2; ++n)
#pragma unroll
                        for (int j = 0; j < 4; ++j) acc[ai][bj][m][n][j] = sigmoidf_(acc[ai][bj][m][n][j]);
#pragma unroll
        for (int bj = 0; bj < 2; ++bj) {
            if (u.pn * BM + wc * 64 < 384) {
#pragma unroll
                for (int ai = 0; ai < 2; ++ai)
#pragma unroll
                    for (int m = 0; m < 4; ++m) {
                        const int lane_ = opaque_lane(), fr = lane_ & 15, fq = lane_ >> 4;
                        const unsigned row = (unsigned)(u.pm * BM + wr * 64 + fr + ai * HALF + m * 16), col = (unsigned)(u.pn * BM + wc * 64 + 8 * fq + bj * 32);
                        const u32x4 yp = *(const u32x4*)(ypre + (row * 384u + col));
                        const f32x4 v0 = acc[ai][bj][m][0], v1 = acc[ai][bj][m][1];
                        u32x4 w;
                        w.x = pk_bf16(bf_lo(yp.x) * v0[0], bf_hi(yp.x) * v0[1]);
                        w.y = pk_bf16(bf_lo(yp.y) * v0[2], bf_hi(yp.y) * v0[3]);
                        w.z = pk_bf16(bf_lo(yp.z) * v1[0], bf_hi(yp.z) * v1[1]);
                        w.w = pk_bf16(bf_lo(yp.w) * v1[2], bf_hi(yp.w) * v1[3]);
                        *(u32x4*)(ycat + (row * 1024u + col)) = w;
                    }
            }
        }
    }
};
struct EpiY {
    static constexpr bool APERM = false;
    bf16_t* y; float* rss;
    DI void begin(const Unit&, LAS unsigned char*) const {}
    DI void operator()(Acc& acc, const Unit& u, const Unit&, bool, int, LAS unsigned char*, int wr, int wc) const {
        const int lane_ = opaque_lane(), fr = lane_ & 15, fq = lane_ >> 4;
        const int row0 = u.pm * BM + wr * 64 + fr, col0 = u.pn * BM + wc * 64 + 8 * fq;
#pragma unroll
        for (int ai = 0; ai < 2; ++ai)
#pragma unroll
            for (int m = 0; m < 4; ++m) { const size_t row = (size_t)(row0 + ai * HALF + m * 16); float s = 0.f;
#pragma unroll
                for (int bj = 0; bj < 2; ++bj) { const f32x4 v0 = acc[ai][bj][m][0], v1 = acc[ai][bj][m][1];
                    s += (v0[0] * v0[0] + v0[1] * v0[1]) + (v0[2] * v0[2] + v0[3] * v0[3]) + (v1[0] * v1[0] + v1[1] * v1[1]) + (v1[2] * v1[2] + v1[3] * v1[3]);
                    u32x4 w; w.x = pk_bf16(v0[0], v0[1]); w.y = pk_bf16(v0[2], v0[3]); w.z = pk_bf16(v1[0], v1[1]); w.w = pk_bf16(v1[2], v1[3]);
                    __builtin_nontemporal_store(w, (u32x4*)(y + row * 1024 + col0 + bj * 32)); }
                s += bperm(s, lane_ ^ 16); s += bperm(s, lane_ ^ 32);
                if (fq == 0) rss[row * 16 + u.pn * 4 + wc] = s; }
    }
};
DI float dpp_prev(float cur, float prevreg) {
    const int t = __builtin_amdgcn_update_dpp(0, __float_as_int(prevreg), 0x121, 0xf, 0xf, false);
    return __int_as_float(__builtin_amdgcn_update_dpp(t, __float_as_int(cur), 0x111, 0xf, 0xf, false));
}
DI float dpp_next(float cur, float nextreg) {
    const int t = __builtin_amdgcn_update_dpp(0, __float_as_int(nextreg), 0x12f, 0xf, 0xf, false);
    return __int_as_float(__builtin_amdgcn_update_dpp(t, __float_as_int(cur), 0x101, 0xf, 0xf, false));
}
DI f32x4 dpp_shr1_v(const f32x4 v) { f32x4 r;
#pragma unroll
    for (int j = 0; j < 4; ++j) r[j] = __int_as_float(__builtin_amdgcn_update_dpp(__float_as_int(v[j]), __float_as_int(v[j]), 0x111, 0xf, 0xf, false));
    return r; }
DI f32x4 dpp_shl1_v(const f32x4 v) { f32x4 r;
#pragma unroll
    for (int j = 0; j < 4; ++j) r[j] = __int_as_float(__builtin_amdgcn_update_dpp(__float_as_int(v[j]), __float_as_int(v[j]), 0x101, 0xf, 0xf, false));
    return r; }
struct EpiUp {
    static constexpr bool APERM = true;
    bf16_t* act; bf16_t* edge; const float* cw; const float* cb;
    DI float ldw(const Unit& u, int idx) const { const int arr = idx >> 8, col = idx & 255, chn = (col >> 7) * 2816 + u.pn * 128 + (col & 127); return arr < 3 ? cw[arr * 5632 + chn] : cb[chn]; }
    DI void begin(const Unit& u, LAS unsigned char* lds) const {
        const int t = otid(); LAS float* wb = (LAS float*)(lds + STAGE_BYTES);
        wb[t] = ldw(u, t); wb[t + 512] = ldw(u, t + 512);
    }
    DI void operator()(Acc& acc, const Unit& u, const Unit& nx, bool has_next, int ui, LAS unsigned char* lds, int wr, int wc) const {
        const int t_ = otid();
        float pa = 0.f, pb = 0.f;
        if (has_next) { pa = ldw(nx, t_); pb = ldw(nx, t_ + 512); }
        const LAS float* wb = (const LAS float*)(lds + STAGE_BYTES) + (ui & 1) * 1024;
        {
            const int l_ = opaque_lane(), fr = l_ & 15, ch0 = u.pn * 128 + wc * 32 + 8 * (l_ >> 4);
            if (fr == 0 || fr == 15) {
                const int slot0 = fr == 0 ? 0 : 2;
#pragma unroll
                for (int ai = 0; ai < 2; ++ai) { const int seg = u.pm * 4 + ai * 2 + wr;
#pragma unroll
                    for (int bj = 0; bj < 2; ++bj)
#pragma unroll
                        for (int n = 0; n < 2; ++n) {
                            const f32x4 a = fr == 0 ? acc[ai][bj][0][n] : acc[ai][bj][2][n], b = fr == 0 ? acc[ai][bj][1][n] : acc[ai][bj][3][n];
                            u32x2 g2; g2.x = pk_bf16(a[0], a[1]); g2.y = pk_bf16(a[2], a[3]);
                            u32x2 h2; h2.x = pk_bf16(b[0], b[1]); h2.y = pk_bf16(b[2], b[3]);
                            *(u32x2*)(edge + (unsigned)(((seg * 4 + slot0) * 2 + bj) * DFF + ch0 + 4 * n)) = g2;
                            *(u32x2*)(edge + (unsigned)(((seg * 4 + slot0 + 1) * 2 + bj) * DFF + ch0 + 4 * n)) = h2; } }
            }
        }
#pragma unroll
        for (int bj = 0; bj < 2; ++bj)
#pragma unroll
            for (int n = 0; n < 2; ++n) {
                const int l_ = opaque_lane();
                const int wi = bj * 128 + wc * 32 + 8 * (l_ >> 4) + 4 * n;
                const f32x4 w0 = *(const LAS f32x4*)(wb + wi), w1 = *(const LAS f32x4*)(wb + 256 + wi), w2 = *(const LAS f32x4*)(wb + 512 + wi), bb = *(const LAS f32x4*)(wb + 768 + wi);
#pragma unroll
                for (int ai = 0; ai < 2; ++ai) {
                    const f32x4 X0 = acc[ai][bj][0][n], X1 = acc[ai][bj][1][n], X2 = acc[ai][bj][2][n], X3 = acc[ai][bj][3][n];
                    const f32x4 P = dpp_shr1_v(X3), N = dpp_shl1_v(X0);
                    f32x4 Y0 = w0 * P + w1 * X0 + w2 * X1 + bb, Y1 = w0 * X0 + w1 * X1 + w2 * X2 + bb, Y2 = w0 * X1 + w1 * X2 + w2 * X3 + bb, Y3 = w0 * X2 + w1 * X3 + w2 * N + bb;
                    if (bj == 0) {
#pragma unroll
                        for (int j = 0; j < 4; ++j) { Y0[j] = gelu_tanh(Y0[j]); Y1[j] = gelu_tanh(Y1[j]); Y2[j] = gelu_tanh(Y2[j]); Y3[j] = gelu_tanh(Y3[j]); }
                    }
                    acc[ai][bj][0][n] = Y0; acc[ai][bj][1][n] = Y1; acc[ai][bj][2][n] = Y2; acc[ai][bj][3][n] = Y3;
                }
                asm volatile("" ::: "memory");
            }
        {
            const int l_ = opaque_lane(), fr = l_ & 15, ch0 = u.pn * 128 + wc * 32 + 8 * (l_ >> 4);
#pragma unroll
            for (int ai = 0; ai < 2; ++ai)
#pragma unroll
                for (int m = 0; m < 4; ++m) {
                    const unsigned row = (unsigned)(u.pm * BM + ai * HALF + wr * 64 + 4 * fr + m);
                    const f32x4 g0 = acc[ai][0][m][0], v0 = acc[ai][1][m][0], g1 = acc[ai][0][m][1], v1 = acc[ai][1][m][1];
                    u32x4 w; w.x = pk_bf16(g0[0] * v0[0], g0[1] * v0[1]); w.y = pk_bf16(g0[2] * v0[2], g0[3] * v0[3]);
                    w.z = pk_bf16(g1[0] * v1[0], g1[1] * v1[1]); w.w = pk_bf16(g1[2] * v1[2], g1[3] * v1[3]);
                    __builtin_nontemporal_store(w, (u32x4*)(act + (row * (unsigned)DFF + (unsigned)ch0)));
                }
        }
        if (has_next) { LAS float* wn = (LAS float*)(lds + STAGE_BYTES) + ((ui + 1) & 1) * 1024; wn[t_] = pa; wn[t_ + 512] = pb; }
    }
};

struct SchedInproj {
    const char* h; const char* win; const char* wpq; char* z; char* pqt; TileMap m1, m2; int bid;
    DI bool next(int i, Unit& u) const {
        const int L = i * (int)gridDim.x + bid; if (L >= 768) return false;
        int pm, pn;
        if (L < 512) { m1.get(L, pm, pn); u.A = h + (size_t)pm * 256 * 1024 * 2; u.B = win + (size_t)pn * 256 * 1024 * 2; u.C = z + ((size_t)pm * 256 * 1024 + pn * 256) * 2; u.ldc = 1024; u.kind = 0; }
        else { m2.get(L - 512, pm, pn); u.A = wpq + (size_t)pm * 256 * 1024 * 2; u.B = h + (size_t)pn * 256 * 1024 * 2; u.C = pqt + ((size_t)pm * 256 * MTOK + pn * 256) * 2; u.ldc = MTOK; u.kind = 1; }
        u.pm = pm; u.pn = pn; return true;
    }
};
struct SchedPlain {
    const char* A; const char* B; int K; int total; TileMap tm; int bid;
    DI bool next(int i, Unit& u) const {
        const int L = i * (int)gridDim.x + bid; if (L >= total) return false;
        int pm, pn; tm.get(L, pm, pn);
        u.A = A + (size_t)pm * 256 * K * 2; u.B = B + (size_t)pn * 256 * K * 2; u.C = nullptr; u.ldc = 0; u.pm = pm; u.pn = pn; u.kind = 0; return true;
    }
};
struct SchedOne { Unit u0; DI bool next(int i, Unit& u) const { if (i > 0) return false; u = u0; return true; } };

DI void tconv_tile(LAS float* tile, const float* src, int ld_src, int k0, int srccol, bf16_t* dst, int ldd, int n0, int srccol_hi = -2) {
    const int tid = otid();
    __syncthreads();
#pragma unroll
    for (int i = 0; i < 8; ++i) { const int k = (tid >> 6) + 8 * i, n = tid & 63;
        const int sc2 = (srccol_hi != -2 && n >= 32) ? srccol_hi + (n - 32) : srccol + n;
        tile[k * 65 + n] = srccol >= 0 ? src[(size_t)(k0 + k) * ld_src + sc2] : 0.f; }
    __syncthreads();
    const int n = tid >> 3, kc = (tid & 7) * 8;
    float v[8];
#pragma unroll
    for (int j = 0; j < 8; ++j) v[j] = tile[(kc + j) * 65 + n];
    u32x4 w; w.x = pk_bf16(v[0], v[1]); w.y = pk_bf16(v[2], v[3]); w.z = pk_bf16(v[4], v[5]); w.w = pk_bf16(v[6], v[7]);
    *(u32x4*)(dst + (size_t)(n0 + n) * ldd + k0 + kc) = w;
}

DI void phase_prep(const Params& p, LAS unsigned char* lds) {
    const int tid = otid(), nblk = gridDim.x, bid = obid();
    LAS float* tile = (LAS float*)lds;
    for (int l = 0; l < NL; ++l) {
        unsigned char* wl = p.ws + l * LAYER_W;
        const float* w_in = p.in[I_WIN] + (size_t)l * 1024 * 1280;
        const float* w_glu = p.in[I_WGLU] + (size_t)l * 384 * 384;
        const float* w_out = p.in[I_WOUT] + (size_t)l * 1024 * 1024;
        const float* w_up = p.in[I_WUP] + (size_t)l * 1024 * 5632;
        const float* w_dn = p.in[I_WDOWN] + (size_t)l * 2816 * 1024;
        const float* w_fft = p.in[I_WFFT] + (size_t)l * 4 * 64 * 64;
        for (int j = bid; j < 2608; j += nblk) {
            if (j < 256) { const int kc = j >> 4, nc = j & 15; tconv_tile(tile, w_in, 1280, kc * 64, (nc < 6 ? nc : nc + 4) * 64, (bf16_t*)(wl + O_WIN), 1024, nc * 64); }
            else if (j < 304) { const int q = j - 256, kc = q >> 3, nc = q & 7; tconv_tile(tile, w_glu, 384, kc * 64, nc < 6 ? nc * 64 : -1, (bf16_t*)(wl + O_WGLU), 384, nc * 64); }
            else if (j < 496) { const int q = j - 304; int kc = q >> 4; const int nc = q & 15; kc = kc < 6 ? kc : kc + 4; tconv_tile(tile, w_out, 1024, kc * 64, nc * 64, (bf16_t*)(wl + O_WOUT), 1024, nc * 64); }
            else if (j < 1904) { const int q = j - 496, kc = q / 88, nc = q % 88, pn = nc >> 2, w4 = nc & 3;
                tconv_tile(tile, w_up, 5632, kc * 64, pn * 128 + w4 * 32, (bf16_t*)(wl + O_WUP), 1024, nc * 64, 2816 + pn * 128 + w4 * 32); }
            else { const int q = j - 1904, kc = q >> 4, nc = q & 15; tconv_tile(tile, w_dn, 1024, kc * 64, nc * 64, (bf16_t*)(wl + O_WDN), 2816, nc * 64); }
        }
        for (int j = (bid + nblk - 64 - 128 * l) % nblk; j < 64; j += nblk) {
            const int kc = j >> 2, hh = j & 3;
            __syncthreads();
#pragma unroll
            for (int i = 0; i < 8; ++i) { const int k = (tid >> 6) + 8 * i, d = tid & 63; tile[k * 65 + d] = w_in[(size_t)(kc * 64 + k) * 1280 + 384 + hh * 64 + d]; }
            LAS float* tab = tile + 64 * 65;
            if (tid < 64) { float s, c; sincospif((float)tid / 32.0f, &s, &c); tab[tid] = c * 0.125f; tab[64 + tid] = s * 0.125f; }
            __syncthreads();
            const int r = tid >> 2, part = r >> 6, e = r & 63, kg = (tid & 3) * 16;
            float o[16];
#pragma unroll
            for (int q = 0; q < 16; ++q) o[q] = 0.f;
            for (int d = 0; d < 64; ++d) { const float tv = tab[part * 64 + ((d * e) & 63)];
#pragma unroll
                for (int q = 0; q < 16; ++q) o[q] += tile[(kg + q) * 65 + d] * tv; }
            bf16_t* dst = (bf16_t*)(wl + O_WPQ) + (size_t)(part * 256 + hh * 64 + e) * 1024 + kc * 64 + kg;
            u32x4 w0, w1; w0.x = pk_bf16(o[0], o[1]); w0.y = pk_bf16(o[2], o[3]); w0.z = pk_bf16(o[4], o[5]); w0.w = pk_bf16(o[6], o[7]);
            w1.x = pk_bf16(o[8], o[9]); w1.y = pk_bf16(o[10], o[11]); w1.z = pk_bf16(o[12], o[13]); w1.w = pk_bf16(o[14], o[15]);
            *(u32x4*)dst = w0; *(u32x4*)(dst + 8) = w1;
        }
        for (int j = (bid + nblk - 128 - 128 * l + 2 * nblk) % nblk; j < 64; j += nblk) {
            const int hh = j >> 4, nc = j & 15;
            LAS float* tf = tile + 64 * 65;
            __syncthreads();
#pragma unroll
            for (int i = 0; i < 8; ++i) { const int e = (tid >> 6) + 8 * i, n = tid & 63;
                tile[e * 65 + n] = w_out[(size_t)(384 + hh * 64 + e) * 1024 + nc * 64 + n];
                tf[e * 65 + n] = w_fft[(size_t)hh * 4096 + e * 64 + n]; }
            __syncthreads();
            const int n = tid >> 3, dg = (tid & 7) * 8;
            float o[8];
#pragma unroll
            for (int q = 0; q < 8; ++q) o[q] = 0.f;
            for (int e = 0; e < 64; ++e) { const float wv = tile[e * 65 + n];
#pragma unroll
                for (int q = 0; q < 8; ++q) o[q] += tf[(dg + q) * 65 + e] * wv; }
            u32x4 w; w.x = pk_bf16(o[0], o[1]); w.y = pk_bf16(o[2], o[3]); w.z = pk_bf16(o[4], o[5]); w.w = pk_bf16(o[6], o[7]);
            *(u32x4*)((bf16_t*)(wl + O_WOUT) + (size_t)(nc * 64 + n) * 1024 + 384 + hh * 64 + dg) = w;
        }
        {
            const float* lam_re = p.in[I_LAMRE] + (size_t)l * 2 * 24 * 64; const float* lam_im = p.in[I_LAMIM] + (size_t)l * 2 * 24 * 64;
            const float* log_dt = p.in[I_LOGDT] + (size_t)l * 2 * 24;
            const float* b_re = p.in[I_BRE] + (size_t)l * 2 * 24 * 64 * 16; const float* b_im = p.in[I_BIM] + (size_t)l * 2 * 24 * 64 * 16;
            const float* c_re = p.in[I_CRE] + (size_t)l * 24 * 16 * 64; const float* c_im = p.in[I_CIM] + (size_t)l * 24 * 16 * 64;
            float* sa = (float*)(wl + O_SA); bf16_t* sb = (bf16_t*)(wl + O_SB); bf16_t* sc = (bf16_t*)(wl + O_SC);
            for (int idx = bid * NTHREADS + tid; idx < 2 * 24 * 64; idx += nblk * NTHREADS) {
                const int pp = idx & 63, g = (idx >> 6) % 24, dir = idx / (64 * 24);
                const float lr = lam_re[idx], li = lam_im[idx], dt = expf(log_dt[dir * 24 + g]);
                const float mag = expf(lr * dt); float sn, cs; sincosf(li * dt, &sn, &cs);
                const float ar = mag * cs, ai = mag * sn;
                sa[((dir * 24 + g) * 2 + 0) * 64 + pp] = ar; sa[((dir * 24 + g) * 2 + 1) * 64 + pp] = ai;
                const float xr = ar - 1.0f, xi = ai, den = 1.0f / (lr * lr + li * li);
                const float fr_ = (xr * lr + xi * li) * den, fi_ = (xi * lr - xr * li) * den;
                for (int ch = 0; ch < 16; ++ch) {
                    const float br = b_re[(size_t)idx * 16 + ch], bi = b_im[(size_t)idx * 16 + ch];
                    const float vr = fr_ * br - fi_ * bi, vi = fr_ * bi + fi_ * br;
                    const int lane = (pp & 31) + 32 * (ch >> 3), j = ch & 7, pt = pp >> 5;
                    sb[((size_t)((dir * 24 + g) * 4 + 0 + pt) * 64 + lane) * 8 + j] = f2bf(vr);
                    sb[((size_t)((dir * 24 + g) * 4 + 2 + pt) * 64 + lane) * 8 + j] = f2bf(vi);
                }
                {
                    const int pt = pp >> 5, p5 = pp & 31, s = p5 >> 4, rem = p5 & 15, hh = (rem >> 2) & 1, j = ((rem >> 3) << 2) | (rem & 3);
                    for (int r = 0; r < 32; ++r) {
                        const float c_r = c_re[((size_t)g * 16 + (r & 15)) * 64 + pp], c_i = c_im[((size_t)g * 16 + (r & 15)) * 64 + pp];
                        const float cr = r < 16 ? c_r : c_r * ar - c_i * ai, ci = r < 16 ? -c_i : -(c_r * ai + c_i * ar);
                        const int lane = r + 32 * hh;
                        sc[((size_t)(((dir * 24 + g) * 4 + 0 + pt) * 2 + s) * 64 + lane) * 8 + j] = f2bf(cr);
                        sc[((size_t)(((dir * 24 + g) * 4 + 2 + pt) * 2 + s) * 64 + lane) * 8 + j] = f2bf(ci);
                    }
                }
            }
            bf16_t* cbt = (bf16_t*)(wl + O_CB);
            {
                const int lane_ = tid & 63;
                for (int w = bid * 8 + (tid >> 6); w < 2 * 24 * 256; w += nblk * 8) {
                    const int c = w & 15, ch = (w >> 4) & 15, g = (w >> 8) % 24, dir = w / (256 * 24);
                    const int li = (dir * 24 + g) * 64 + lane_;
                    const float dt = expf(log_dt[dir * 24 + g]), lr = lam_re[li], li_ = lam_im[li];
                    const float mag = expf(lr * dt); float sn, cs; sincosf(li_ * dt, &sn, &cs);
                    const float xr = mag * cs - 1.0f, xi = mag * sn, den = 1.0f / (lr * lr + li_ * li_);
                    const float f_r = (xr * lr + xi * li_) * den, f_i = (xi * lr - xr * li_) * den;
                    const float br = b_re[(size_t)li * 16 + c], bi = b_im[(size_t)li * 16 + c];
                    const float vr = f_r * br - f_i * bi, vi = f_r * bi + f_i * br;
                    float acc = c_re[((size_t)g * 16 + ch) * 64 + lane_] * vr - c_im[((size_t)g * 16 + ch) * 64 + lane_] * vi;
                    acc += bperm(acc, lane_ ^ 32); acc += bperm(acc, lane_ ^ 16); acc += bperm(acc, lane_ ^ 8); acc += bperm(acc, lane_ ^ 4); acc += bperm(acc, lane_ ^ 2); acc += bperm(acc, lane_ ^ 1);
                    if (lane_ == 0) { const size_t base = ((size_t)(dir * 24 + g) * 64 + 32 * (c >> 3)) * 8 + (c & 7);
                        cbt[base + (size_t)(16 + ch) * 8] = f2bf(acc); cbt[base + (size_t)ch * 8] = 0; }
                }
            }
        }
    }
    {
        bf16_t* dft = (bf16_t*)(p.ws + O_DFT);
        const float sc_ = 0.02209708691f;
        for (int idx = bid * NTHREADS + tid; idx < 2048 * 256; idx += nblk * NTHREADS) {
            const int row = idx >> 8, k8 = (idx & 255) * 8, j = (row & 1023) + 1;
            float v[8];
#pragma unroll
            for (int q = 0; q < 8; ++q) { const int m = (j * (k8 + q)) & 2047; float sn, cs; sincospif((float)m * (1.0f / 1024.0f), &sn, &cs); v[q] = (row < 1024 ? cs : sn) * sc_; }
            u32x4 w; w.x = pk_bf16(v[0], v[1]); w.y = pk_bf16(v[2], v[3]); w.z = pk_bf16(v[4], v[5]); w.w = pk_bf16(v[6], v[7]);
            *(u32x4*)(dft + (size_t)row * 2048 + k8) = w;
        }
    }
    {
        float* mod = (float*)(p.ws + O_MOD);
        LAS float* cl = (LAS float*)lds;
        LAS float* red = cl + 16 * 1024;
        for (int j = (bid + nblk - 32) % nblk; j < 192; j += nblk) {
            const int l = j / 96, c0 = (j % 96) * 64;
            __syncthreads();
            for (int i = tid; i < 16 * 1024; i += NTHREADS) cl[i] = p.in[I_C][i];
            __syncthreads();
            const int kg = tid >> 6, col = tid & 63;
            const float* w = p.in[I_WADA] + (size_t)l * 1024 * 6144 + c0 + col;
            float a[16];
#pragma unroll
            for (int b = 0; b < 16; ++b) a[b] = 0.f;
            for (int k0 = kg * 128; k0 < kg * 128 + 128; k0 += 16) {
                float wv[16];
#pragma unroll
                for (int q = 0; q < 16; ++q) wv[q] = w[(size_t)(k0 + q) * 6144];
#pragma unroll
                for (int q = 0; q < 16; ++q)
#pragma unroll
                    for (int b = 0; b < 16; ++b) a[b] += cl[b * 1024 + k0 + q] * wv[q];
            }
#pragma unroll
            for (int b = 0; b < 16; ++b) red[(kg * 16 + b) * 64 + col] = a[b];
            __syncthreads();
            for (int o = tid; o < 16 * 64; o += NTHREADS) { const int b = o >> 6, cc = o & 63; float s = p.in[I_BADA][l * 6144 + c0 + cc];
#pragma unroll
                for (int q = 0; q < 8; ++q) s += red[(q * 16 + b) * 64 + cc];
                mod[((size_t)l * 16 + b) * 6144 + c0 + cc] = s; }
        }
    }
}

DI float wave_sum(float v, int lane) {
    v += bperm(v, lane ^ 32); v += bperm(v, lane ^ 16); v += bperm(v, lane ^ 8); v += bperm(v, lane ^ 4); v += bperm(v, lane ^ 2); v += bperm(v, lane ^ 1); return v; }
template <bool XB>
DI void phase_rows(const float* xin, const bf16_t* xin_b, float* xout, bf16_t* xout_b, const bf16_t* y, const float* rss, const float* modr, int gate_off, const float* g_post, bool do_res,
                   bool do_h, const float* modh, int sh_off, int sc_off, const float* g_pre, bf16_t* hout) {
    const int tid_ = otid(), lane = tid_ & 63, wid = tid_ >> 6;
#define RCOL(i) (lane * 8 + 512 * ((i) >> 1) + 4 * ((i) & 1))
    f32x4 gp[4], gq[4];
#pragma unroll
    for (int i = 0; i < 4; ++i) { const int c = RCOL(i); gp[i] = do_res ? *(const f32x4*)(g_post + c) : (f32x4){0.f, 0.f, 0.f, 0.f}; gq[i] = do_h ? *(const f32x4*)(g_pre + c) : (f32x4){0.f, 0.f, 0.f, 0.f}; }
    const int rstride = (int)gridDim.x * 32;
    u32x4 xr[4][2], yr[4][2]; float rsr[4];
#define ROWS_LOAD_RAW(R0) do { _Pragma("unroll") for (int r = 0; r < 4; ++r) { _Pragma("unroll") for (int h = 0; h < 2; ++h) { \
        xr[r][h] = *(const u32x4*)(xin_b + (size_t)((R0) + r) * 1024 + lane * 8 + 512 * h); yr[r][h] = *(const u32x4*)(y + (size_t)((R0) + r) * 1024 + lane * 8 + 512 * h); } \
        rsr[r] = rss[(size_t)((R0) + r) * 16 + (lane & 15)]; } } while (0)
    const int row_first = (obid() * 8 + wid) * 4;
    if (XB) { if (row_first < MTOK) ROWS_LOAD_RAW(row_first); }
    for (int row0 = row_first; row0 < MTOK; row0 += rstride) {
        const int b = row0 >> 11;
        f32x4 x[4][4]; u32x4 yw[4][2]; float rs[4];
        if (XB) {
#pragma unroll
            for (int r = 0; r < 4; ++r) {
#pragma unroll
                for (int h = 0; h < 2; ++h) { const u32x4 w = xr[r][h]; yw[r][h] = yr[r][h];
                    x[r][2 * h] = (f32x4){bf_lo(w.x), bf_hi(w.x), bf_lo(w.y), bf_hi(w.y)}; x[r][2 * h + 1] = (f32x4){bf_lo(w.z), bf_hi(w.z), bf_lo(w.w), bf_hi(w.w)}; }
                rs[r] = rsr[r]; }
            if (row0 + rstride < MTOK) ROWS_LOAD_RAW(row0 + rstride);
        } else {
#pragma unroll
            for (int r = 0; r < 4; ++r)
#pragma unroll
                for (int i = 0; i < 4; ++i) x[r][i] = *(const f32x4*)(xin + (size_t)(row0 + r) * 1024 + RCOL(i));
        }
        if (do_res) {
            if (!XB) {
#pragma unroll
                for (int r = 0; r < 4; ++r) {
#pragma unroll
                    for (int h = 0; h < 2; ++h) yw[r][h] = *(const u32x4*)(y + (size_t)(row0 + r) * 1024 + lane * 8 + 512 * h);
                    rs[r] = rss[(size_t)(row0 + r) * 16 + (lane & 15)];
                }
            }
            float rstdy[4];
#pragma unroll
            for (int r = 0; r < 4; ++r) { float ss = rs[r]; ss += bperm(ss, lane ^ 1); ss += bperm(ss, lane ^ 2); ss += bperm(ss, lane ^ 4); ss += bperm(ss, lane ^ 8); rstdy[r] = rsqrtf(ss * (1.0f / 1024.0f) + 1e-6f); }
#pragma unroll
            for (int h = 0; h < 2; ++h) {
                const f32x4 gt0 = *(const f32x4*)(modr + (size_t)b * 6144 + gate_off + RCOL(2 * h)) * gp[2 * h], gt1 = *(const f32x4*)(modr + (size_t)b * 6144 + gate_off + RCOL(2 * h + 1)) * gp[2 * h + 1];
#pragma unroll
                for (int r = 0; r < 4; ++r) {
                    const u32x4 w = yw[r][h]; const float rstd = rstdy[r];
                    f32x4& a = x[r][2 * h]; f32x4& c2 = x[r][2 * h + 1];
                    a[0] += gt0[0] * (bf_lo(w.x) * rstd); a[1] += gt0[1] * (bf_hi(w.x) * rstd); a[2] += gt0[2] * (bf_lo(w.y) * rstd); a[3] += gt0[3] * (bf_hi(w.y) * rstd);
                    c2[0] += gt1[0] * (bf_lo(w.z) * rstd); c2[1] += gt1[1] * (bf_hi(w.z) * rstd); c2[2] += gt1[2] * (bf_lo(w.w) * rstd); c2[3] += gt1[3] * (bf_hi(w.w) * rstd);
                    if (xout_b) { u32x4 o; o.x = pk_bf16(a[0], a[1]); o.y = pk_bf16(a[2], a[3]); o.z = pk_bf16(c2[0], c2[1]); o.w = pk_bf16(c2[2], c2[3]);
                        *(u32x4*)(xout_b + (size_t)(row0 + r) * 1024 + lane * 8 + 512 * h) = o;
                        a = (f32x4){bf_lo(o.x), bf_hi(o.x), bf_lo(o.y), bf_hi(o.y)}; c2 = (f32x4){bf_lo(o.z), bf_hi(o.z), bf_lo(o.w), bf_hi(o.w)}; }
                    else { *(f32x4*)(xout + (size_t)(row0 + r) * 1024 + RCOL(2 * h)) = a; *(f32x4*)(xout + (size_t)(row0 + r) * 1024 + RCOL(2 * h + 1)) = c2; }
                }
            }
        }
        if (do_h) {
            float rstd[4];
#pragma unroll
            for (int r = 0; r < 4; ++r) { float ss = 0.f;
#pragma unroll
                for (int i = 0; i < 4; ++i) ss += (x[r][i][0] * x[r][i][0] + x[r][i][1] * x[r][i][1]) + (x[r][i][2] * x[r][i][2] + x[r][i][3] * x[r][i][3]);
                rstd[r] = rsqrtf(wave_sum(ss, lane) * (1.0f / 1024.0f) + 1e-6f); }
#pragma unroll
            for (int h = 0; h < 2; ++h) {
                f32x4 gg[2], sh[2];
#pragma unroll
                for (int q = 0; q < 2; ++q) { const int c = RCOL(2 * h + q);
                    const f32x4 sc = *(const f32x4*)(modh + (size_t)b * 6144 + sc_off + c); sh[q] = *(const f32x4*)(modh + (size_t)b * 6144 + sh_off + c); gg[q] = gq[2 * h + q] * (sc + 1.0f); }
#pragma unroll
                for (int r = 0; r < 4; ++r) {
                    const f32x4 a = x[r][2 * h] * rstd[r] * gg[0] + sh[0], c2 = x[r][2 * h + 1] * rstd[r] * gg[1] + sh[1];
                    u32x4 o; o.x = pk_bf16(a[0], a[1]); o.y = pk_bf16(a[2], a[3]); o.z = pk_bf16(c2[0], c2[1]); o.w = pk_bf16(c2[2], c2[3]);
                    *(u32x4*)(hout + (size_t)(row0 + r) * 1024 + lane * 8 + 512 * h) = o; }
            }
        }
    }
#undef RCOL
#undef ROWS_LOAD_RAW
}

DI bf16x8 ld_u(const bf16_t* p) { return *(const bf16x8*)p; }
DI void ssm_item(const Params& p, LAS unsigned char* lds, int l, int item) {
    const int tid = otid(), wid = tid >> 6, lane = tid & 63, n = lane & 31, hh = lane >> 5;
    const int g = item >> 2, b = (item & 3) * 4 + (wid >> 1), dir = wid & 1;
    unsigned char* wl = p.ws + l * LAYER_W;
    const u32x4 ctab0 = *(const u32x4*)(wl + O_SC + (size_t)g * 8192 + tid * 16), ctab1 = *(const u32x4*)(wl + O_SC + (size_t)(24 + g) * 8192 + tid * 16);
    const f32x4 atab = *(const f32x4*)((const float*)(wl + O_SA) + (size_t)g * 128 + ((tid & 63) >> 5) * 24 * 128 + (tid & 31) * 4);
    __syncthreads();
    *(LAS u32x4*)(lds + tid * 16) = ctab0; *(LAS u32x4*)(lds + 8192 + tid * 16) = ctab1;
    if (tid < 64) *(LAS f32x4*)(lds + 16384 + tid * 16) = atab;
    __syncthreads();
    const LAS float* la = (const LAS float*)(lds + 16384) + dir * 128 + 4 * hh;
#define SSM_LDA(pt) f32x16 are_, aim_; _Pragma("unroll") for (int q_ = 0; q_ < 4; ++q_) { const f32x4 r4 = *(const LAS f32x4*)(la + (pt) * 32 + 8 * q_), i4 = *(const LAS f32x4*)(la + 64 + (pt) * 32 + 8 * q_); \
        _Pragma("unroll") for (int j_ = 0; j_ < 4; ++j_) { are_[4 * q_ + j_] = r4[j_]; aim_[4 * q_ + j_] = i4[j_]; } }
    bf16x8 bop[4];
#pragma unroll
    for (int t = 0; t < 4; ++t) bop[t] = *(const bf16x8*)((const bf16_t*)(wl + O_SB) + ((size_t)((dir * 24 + g) * 4 + t) * 64 + lane) * 8);
    const bf16_t* ut = (const bf16_t*)(p.ws + O_UT) + (size_t)(b * 24 + g) * (64 * 32 * 16);
    const long tstride = dir ? -512 : 512;
    const bf16_t* ubase = ut + (dir ? (63 * 32 + (31 - n)) * 16 : n * 16) + 8 * hh;
    f32x16 hre[2], him[2];
#pragma unroll
    for (int pt = 0; pt < 2; ++pt)
#pragma unroll
        for (int i = 0; i < 16; ++i) { hre[pt][i] = 0.f; him[pt][i] = 0.f; }
    {
        const int widu = __builtin_amdgcn_readfirstlane(wid);
        LAS unsigned char* ust = lds + 20480 + widu * 16384;
#pragma unroll
        for (int q = 0; q < 8; ++q) __builtin_amdgcn_global_load_lds((const unsigned*)(ubase + q * tstride), (LAS unsigned*)(ust + q * 1024), 16, 0, 0);
        for (int i0 = 0; i0 < 64; i0 += 8) {
            const int cur = (i0 >> 3) & 1;
            asm volatile("s_waitcnt vmcnt(0)" ::: "memory");
            if (i0 + 8 < 64) {
#pragma unroll
                for (int q = 0; q < 8; ++q) __builtin_amdgcn_global_load_lds((const unsigned*)(ubase + (i0 + 8 + q) * tstride), (LAS unsigned*)(ust + (cur ^ 1) * 8192 + q * 1024), 16, 0, 0);
            }
#pragma unroll
            for (int q = 0; q < 8; ++q) {
                const bf16x8 uc = *(const LAS bf16x8*)(ust + cur * 8192 + q * 1024 + lane * 16);
#pragma unroll
                for (int pt = 0; pt < 2; ++pt) {
                    asm volatile("" ::: "memory");
                    SSM_LDA(pt)
                    const f32x16 tr = are_ * hre[pt] - aim_ * him[pt], ti = are_ * him[pt] + aim_ * hre[pt];
                    hre[pt] = MFMA32(bop[pt], uc, tr); him[pt] = MFMA32(bop[2 + pt], uc, ti);
                }
            }
        }
    }
#pragma unroll
    for (int pt = 0; pt < 2; ++pt) {
        SSM_LDA(pt)
        f32x16 pr = are_, pi = aim_;
#pragma unroll
        for (int s = 0; s < 6; ++s) { const f32x16 nr = pr * pr - pi * pi, ni = 2.0f * pr * pi; pr = nr; pi = ni; }
#pragma unroll
        for (int d = 1; d < 32; d <<= 1) {
            const bool take = n >= d; const int src = take ? lane - d : lane;
#pragma unroll
            for (int i = 0; i < 16; ++i) {
                const float sr = bperm(hre[pt][i], src), si = bperm(him[pt][i], src);
                if (take) { hre[pt][i] += pr[i] * sr - pi[i] * si; him[pt][i] += pr[i] * si + pi[i] * sr; }
            }
            const f32x16 nr = pr * pr - pi * pi, ni = 2.0f * pr * pi; pr = nr; pi = ni;
        }
#pragma unroll
        for (int i = 0; i < 16; ++i) { const int src1 = n ? lane - 1 : lane; const float sr = bperm(hre[pt][i], src1), si = bperm(him[pt][i], src1); hre[pt][i] = n ? sr : 0.f; him[pt][i] = n ? si : 0.f; }
        asm volatile("" ::: "memory");
    }
    {
        float* yt = (float*)(p.ws + O_YFB) + (size_t)dir * MTOK * 384 + (size_t)(b * 24 + g) * (64 * 32 * 16);
        float* ybase = yt + (dir ? (63 * 32 + (31 - n)) * 16 : n * 16) + 4 * hh;
        const int widu = __builtin_amdgcn_readfirstlane(wid);
        const bf16x8 cbop = *(const bf16x8*)((const bf16_t*)(wl + O_CB) + ((size_t)(dir * 24 + g) * 64 + lane) * 8);
        f32x16 yacc;
#pragma unroll
        for (int i = 0; i < 16; ++i) yacc[i] = 0.f;
        LAS unsigned char* ust = lds + 20480 + widu * 16384;
#pragma unroll
        for (int q = 0; q < 8; ++q) __builtin_amdgcn_global_load_lds((const unsigned*)(ubase + q * tstride), (LAS unsigned*)(ust + q * 1024), 16, 0, 0);
        for (int i0 = 0; i0 < 64; i0 += 8) {
            const int cur = (i0 >> 3) & 1;
            asm volatile("s_waitcnt vmcnt(0)" ::: "memory");
            if (i0 + 8 < 64) {
#pragma unroll
                for (int q = 0; q < 8; ++q) __builtin_amdgcn_global_load_lds((const unsigned*)(ubase + (i0 + 8 + q) * tstride), (LAS unsigned*)(ust + (cur ^ 1) * 8192 + q * 1024), 16, 0, 0);
            }
#pragma unroll
            for (int q = 0; q < 8; ++q) {
                const bf16x8 uc = *(const LAS bf16x8*)(ust + cur * 8192 + q * 1024 + lane * 16);
#pragma unroll
                for (int pt = 0; pt < 2; ++pt) {
                    asm volatile("" ::: "memory");
                    SSM_LDA(pt)
                    const f32x16 tr = are_ * hre[pt] - aim_ * him[pt], ti = are_ * him[pt] + aim_ * hre[pt];
                    hre[pt] = MFMA32(bop[pt], uc, tr); him[pt] = MFMA32(bop[2 + pt], uc, ti);
                }
                if ((q & 1) == 0) {
                    f32x16 yac2;
#pragma unroll
                    for (int i = 0; i < 16; ++i) { yacc[i] = 0.f; yac2[i] = 0.f; }
#pragma unroll
                    for (int T = 0; T < 2; ++T) {
#pragma unroll
                        for (int s = 0; s < 2; ++s) {
                            const f32x16 hv = hre[T], hw = him[T];
                            const bf16x8 hb = pack8(hv[8 * s], hv[8 * s + 1], hv[8 * s + 2], hv[8 * s + 3], hv[8 * s + 4], hv[8 * s + 5], hv[8 * s + 6], hv[8 * s + 7]);
                            const bf16x8 hc = pack8(hw[8 * s], hw[8 * s + 1], hw[8 * s + 2], hw[8 * s + 3], hw[8 * s + 4], hw[8 * s + 5], hw[8 * s + 6], hw[8 * s + 7]);
                            const bf16x8 cop = *(const LAS bf16x8*)(lds + dir * 8192 + ((T * 2 + s) * 64 + lane) * 16);
                            const bf16x8 coq = *(const LAS bf16x8*)(lds + dir * 8192 + (((2 + T) * 2 + s) * 64 + lane) * 16);
                            yacc = MFMA32(cop, hb, yacc);
                            yac2 = MFMA32(coq, hc, yac2);
                        }
                    }
                    yacc += yac2;
                    float* yp = ybase + (i0 + q) * tstride;
                    *(f32x4*)yp = (f32x4){yacc[0], yacc[1], yacc[2], yacc[3]};
                    *(f32x4*)(yp + 8) = (f32x4){yacc[4], yacc[5], yacc[6], yacc[7]};
                } else {
                    yacc = MFMA32(cbop, uc, yacc);
                    float* yp = ybase + (i0 + q) * tstride;
                    *(f32x4*)yp = (f32x4){yacc[8], yacc[9], yacc[10], yacc[11]};
                    *(f32x4*)(yp + 8) = (f32x4){yacc[12], yacc[13], yacc[14], yacc[15]};
                }
            }
        }
    }
    __syncthreads();
    {
        const float* yf = (const float*)(p.ws + O_YFB) + (size_t)(b * 24 + g) * (64 * 32 * 16); const float* yb = yf + (size_t)MTOK * 384;
        bf16_t* ypre = (bf16_t*)(p.ws + O_YPRE);
        const float* dsk = p.in[I_DSKIP] + l * 384 + g * 16;
        const int t2 = tid & 127;
        const f32x4 d4 = *(const f32x4*)(dsk + (t2 & 3) * 4);
        for (int it = 0; it < 64; it += 8) {
            f32x4 a[8], bb[8]; u32x2 uw[8];
#pragma unroll
            for (int q = 0; q < 8; ++q) { const int idx = t2 + 128 * (it + q), c4 = (idx & 3) * 4, nn = (idx >> 2) & 31, ii = idx >> 7, e = (ii * 32 + nn) * 16 + c4;
                a[q] = *(const f32x4*)(yf + e); bb[q] = *(const f32x4*)(yb + e); uw[q] = *(const u32x2*)(ut + e); }
#pragma unroll
            for (int q = 0; q < 8; ++q) { const int idx = t2 + 128 * (it + q), c4 = (idx & 3) * 4, nn = (idx >> 2) & 31, ii = idx >> 7;
                const size_t tok = (size_t)b * 2048 + 64 * nn + ii;
                const float y0 = a[q][0] + bb[q][0] + d4[0] * bf_lo(uw[q].x), y1 = a[q][1] + bb[q][1] + d4[1] * bf_hi(uw[q].x), y2 = a[q][2] + bb[q][2] + d4[2] * bf_lo(uw[q].y), y3 = a[q][3] + bb[q][3] + d4[3] * bf_hi(uw[q].y);
                u32x2 w; w.x = pk_bf16(gelu_tanh(y0), gelu_tanh(y1)); w.y = pk_bf16(gelu_tanh(y2), gelu_tanh(y3));
                *(u32x2*)(ypre + tok * 384 + g * 16 + c4) = w; }
        }
    }
}

DI void attn_item(const Params& p, LAS unsigned char* lds, int l, int item) {
    const int tid = otid(), wid = tid >> 6, lane = tid & 63, n = lane & 31, hh = lane >> 5;
    const int b = item >> 5, blk = (item >> 1) & 15, kvh = item & 1;
    const bf16_t* z = (const bf16_t*)(p.ws + O_Z);
    bf16_t* ycat = (bf16_t*)(p.ws + O_YCAT);
    constexpr int KROW = 144, VROW = 784, VOFF = 384 * KROW;
    __syncthreads();
    for (int c = tid; c < 3072; c += NTHREADS) {
        const int j = c >> 3, dc = c & 7, pos = blk * 128 - 128 + j;
        u32x4 kv = {0u, 0u, 0u, 0u};
        if (pos >= 0 && pos < 2048) kv = *(const u32x4*)(z + ((size_t)b * 2048 + pos) * 1024 + 768 + kvh * 64 + dc * 8);
        *(LAS u32x4*)(lds + j * KROW + dc * 16) = kv;
    }
    for (int c = tid; c < 3072; c += NTHREADS) {
        const int j = c % 384, dc = c / 384, pos = blk * 128 - 128 + j;
        u32x4 vv = {0u, 0u, 0u, 0u};
        if (pos >= 0 && pos < 2048) vv = *(const u32x4*)(z + ((size_t)b * 2048 + pos) * 1024 + 896 + kvh * 64 + dc * 8);
        LAS bf16_t* vt = (LAS bf16_t*)(lds + VOFF + (dc * 8) * VROW) + j;
        vt[0 * (VROW / 2)] = (bf16_t)(vv.x & 0xffff); vt[1 * (VROW / 2)] = (bf16_t)(vv.x >> 16);
        vt[2 * (VROW / 2)] = (bf16_t)(vv.y & 0xffff); vt[3 * (VROW / 2)] = (bf16_t)(vv.y >> 16);
        vt[4 * (VROW / 2)] = (bf16_t)(vv.z & 0xffff); vt[5 * (VROW / 2)] = (bf16_t)(vv.z >> 16);
        vt[6 * (VROW / 2)] = (bf16_t)(vv.w & 0xffff); vt[7 * (VROW / 2)] = (bf16_t)(vv.w >> 16);
    }
    __syncthreads();
    for (int task = wid; task < 12; task += 8) {
        const int head = kvh * 3 + (task >> 2), qt = task & 3;
        const float slope2 = exp2f(-8.0f * (float)(head + 1) / 6.0f) * 1.442695041f;
        const float sink2 = p.in[I_SINK][l * 6 + head] * 1.442695041f;
        const int qi = 32 * qt + n;
        const size_t tok = (size_t)b * 2048 + blk * 128 + qi;
        bf16x8 qop[4];
#pragma unroll
        for (int s = 0; s < 4; ++s) qop[s] = *(const bf16x8*)(z + tok * 1024 + 384 + head * 64 + 16 * s + 8 * hh);
        f32x16 o0, o1;
#pragma unroll
        for (int i = 0; i < 16; ++i) { o0[i] = 0.f; o1[i] = 0.f; }
        float mrun = sink2, lrun = 0.f;
        float dbase[16];
#pragma unroll
        for (int r = 0; r < 16; ++r) dbase[r] = (float)(128 + n - ((r & 3) + 8 * (r >> 2) + 4 * hh));
        const bool edge_blk = (blk == 0) || (blk == 15);
#pragma unroll 3
        for (int kk = 0; kk < 9; ++kk) {
            const int kt = qt + kk;
            f32x16 sacc;
#pragma unroll
            for (int i = 0; i < 16; ++i) sacc[i] = 0.f;
#pragma unroll
            for (int s = 0; s < 4; ++s) { const bf16x8 kop = *(const LAS bf16x8*)(lds + (kt * 32 + n) * KROW + (16 * s + 8 * hh) * 2); sacc = MFMA32(kop, qop[s], sacc); }
            const int dk = kt - qt;
            const float off = 32.0f * (float)dk;
            float mx = -1e30f;
            if (dk == 0 || dk == 8 || edge_blk) {
#pragma unroll
                for (int r = 0; r < 16; ++r) {
                    const int j = kt * 32 + (r & 3) + 8 * (r >> 2) + 4 * hh, pos = blk * 128 - 128 + j;
                    const float d = dbase[r] - off;
                    const bool valid = fabsf(d) <= 128.0f && pos >= 0 && pos < 2048;
                    const float sc = valid ? sacc[r] * 0.1803368801f - slope2 * fabsf(d) : -1e30f;
                    sacc[r] = sc; mx = fmaxf(mx, sc);
                }
            } else {
#pragma unroll
                for (int r = 0; r < 16; ++r) { const float sc = sacc[r] * 0.1803368801f - slope2 * fabsf(dbase[r] - off); sacc[r] = sc; mx = fmaxf(mx, sc); }
            }
            mx = fmaxf(mx, bperm(mx, lane ^ 32));
            const float mnew = fmaxf(mrun, mx);
            if (__builtin_amdgcn_ballot_w64(mnew != mrun) != 0ull) {
                const float alpha = __builtin_amdgcn_exp2f(mrun - mnew);
                lrun *= alpha; o0 *= alpha; o1 *= alpha; mrun = mnew;
            }
            float ls = 0.f;
#pragma unroll
            for (int r = 0; r < 16; ++r) { const float pv = __builtin_amdgcn_exp2f(sacc[r] - mrun); sacc[r] = pv; ls += pv; }
            lrun += ls;
#pragma unroll
            for (int s = 0; s < 2; ++s) {
                const bf16x8 pb = pack8(sacc[8 * s], sacc[8 * s + 1], sacc[8 * s + 2], sacc[8 * s + 3], sacc[8 * s + 4], sacc[8 * s + 5], sacc[8 * s + 6], sacc[8 * s + 7]);
#pragma unroll
                for (int dt = 0; dt < 2; ++dt) {
                    const LAS unsigned char* vp = lds + VOFF + (dt * 32 + n) * VROW + (kt * 32 + 16 * s + 4 * hh) * 2;
                    const s16x4 lo = *(const LAS s16x4*)vp, hi = *(const LAS s16x4*)(vp + 16);
                    const bf16x8 vop = __builtin_shufflevector(lo, hi, 0, 1, 2, 3, 4, 5, 6, 7);
                    if (dt == 0) o0 = MFMA32(vop, pb, o0); else o1 = MFMA32(vop, pb, o1);
                }
            }
        }
        const float ltot = lrun + bperm(lrun, lane ^ 32);
        const float inv = 1.0f / (ltot + __builtin_amdgcn_exp2f(sink2 - mrun));
        bf16_t* op = ycat + tok * 1024 + 640 + head * 64 + 4 * hh;
#pragma unroll
        for (int q = 0; q < 4; ++q) {
            u32x2 w0; w0.x = pk_bf16(o0[4 * q] * inv, o0[4 * q + 1] * inv); w0.y = pk_bf16(o0[4 * q + 2] * inv, o0[4 * q + 3] * inv);
            u32x2 w1; w1.x = pk_bf16(o1[4 * q] * inv, o1[4 * q + 1] * inv); w1.y = pk_bf16(o1[4 * q + 2] * inv, o1[4 * q + 3] * inv);
            *(u32x2*)(op + 8 * q) = w0; *(u32x2*)(op + 32 + 8 * q) = w1;
        }
    }
}

#define XB_TMO      128
#define XB_XCNT(j)  (256  + 64 * (j))
#define XB_XSUB(j)  (1280 + 64 * (j))
#define XB_XGEN(j)  (2304 + 64 * (j))
#define XB_TOP      3328
#define XB_TOPGEN   3392
#define XB_SPIN_CAP (1u << 20)
DI unsigned xb_ld(unsigned* p) { return __hip_atomic_load(p, __ATOMIC_RELAXED, __HIP_MEMORY_SCOPE_AGENT); }
DI unsigned xb_add(unsigned* p, unsigned v) { return __hip_atomic_fetch_add(p, v, __ATOMIC_RELAXED, __HIP_MEMORY_SCOPE_AGENT); }
DI unsigned xb_xcc_id() { return (unsigned)__builtin_amdgcn_s_getreg((3 << 11) | 20) & 0xFu; }
#define XB_SPIN(cond, bar) do { unsigned _sp = 0; while (cond) { __builtin_amdgcn_s_sleep(1); \
    if ((++_sp & 255u) == 0u) { if (xb_ld(&(bar)[XB_TMO])) break; if (_sp > XB_SPIN_CAP) { atomicAdd(&(bar)[XB_TMO], 1u); break; } } } } while (0)
DI void xcd_barrier_complete(unsigned* bar, unsigned x, unsigned& nloc, unsigned& nx) {
    const unsigned G = gridDim.x;
    unsigned sum, cnt, mine, sp = 0u;
    for (;;) {
        sum = 0u; cnt = 0u; mine = 0u;
#pragma unroll
        for (unsigned j = 0; j < 16; ++j) { const unsigned c = xb_ld(&bar[XB_XCNT(j)]); sum += c; cnt += (c > 0u) ? 1u : 0u; mine = (j == x) ? c : mine; }
        if (sum == G) break;
        __builtin_amdgcn_s_sleep(1);
        if ((++sp & 255u) == 0u) { if (xb_ld(&bar[XB_TMO])) break; if (sp > XB_SPIN_CAP) { atomicAdd(&bar[XB_TMO], 1u); break; } }
    }
    nloc = mine > 0u ? mine : 1u; nx = cnt > 0u ? cnt : 1u;
}
DI void xcd_barrier(unsigned* bar, volatile LAS unsigned* st) {
    asm volatile("s_waitcnt vmcnt(0)" ::: "memory");
    __syncthreads();
    if (otid() == 0) {
        __builtin_amdgcn_s_waitcnt(0);
        const unsigned x = xb_xcc_id();
        unsigned nloc = st[0], nx = st[1];
        if (nloc == 0u) { xcd_barrier_complete(bar, x, nloc, nx); st[0] = nloc; st[1] = nx; }
        const unsigned old = xb_add(&bar[XB_XSUB(x)], 1u);
        const unsigned gen = old / nloc;
        if (old + 1u == (gen + 1u) * nloc) {
            __builtin_amdgcn_fence(__ATOMIC_RELEASE, "agent");
            asm volatile("s_waitcnt vmcnt(0)" ::: "memory");
            const unsigned og = xb_add(&bar[XB_TOP], 1u);
            const unsigned tg = og / nx;
            if (og + 1u == (tg + 1u) * nx) xb_add(&bar[XB_TOPGEN], 1u);
            else XB_SPIN(xb_ld(&bar[XB_TOPGEN]) == tg, bar);
            __builtin_amdgcn_fence(__ATOMIC_ACQUIRE, "agent");
            xb_add(&bar[XB_XGEN(x)], 1u);
            asm volatile("s_waitcnt vmcnt(0)" ::: "memory");
        } else {
            XB_SPIN(xb_ld(&bar[XB_XGEN(x)]) == gen, bar);
            __builtin_amdgcn_fence(__ATOMIC_ACQUIRE, "agent");
            asm volatile("s_waitcnt vmcnt(0)" ::: "memory");
        }
    }
    __syncthreads();
}
#define EN(k) (((PHASE_EN) >> (k)) & 1u)
constexpr int NPHASE = 2 + 9 * NL;
template <unsigned PHASE_EN> __global__ void __launch_bounds__(NTHREADS, 2) fwd_megakernel(Params p_arg) {
    extern __shared__ __attribute__((aligned(16))) unsigned char lds_raw[];
    LAS unsigned char* lds = (LAS unsigned char*)lds_raw;
    cg::grid_group grid = cg::this_grid();
    const int ph_lo = p_arg.ph_lo, ph_hi = p_arg.ph_hi;
    volatile LAS unsigned* xst = (volatile LAS unsigned*)(lds + LDS_BYTES - 32);
    if (threadIdx.x == 0) { xst[0] = 0u; xst[1] = 0u; (void)xb_add((unsigned*)(p_arg.ws + O_CTR + 1024) + XB_XCNT(xb_xcc_id()), 1u); }
    __syncthreads();
    for (int ph = ph_lo; ph < ph_hi; ++ph) {
#if defined(__HIP_DEVICE_COMPILE__)
        const __attribute__((address_space(4))) Params* pp = (const __attribute__((address_space(4))) Params*)__builtin_amdgcn_kernarg_segment_ptr();
        asm volatile("" : "+s"(pp));
        const Params p = *pp;
#else
        const Params p = p_arg;
#endif
        unsigned char* ws = p.ws;
        const float* mod = (const float*)(ws + O_MOD);
        if (ph == 0) { if (EN(0)) phase_prep(p, lds); }
        else if (ph == 1) {
            if (EN(1)) phase_rows<false>(p.in[I_X], nullptr, nullptr, nullptr, nullptr, nullptr, nullptr, 0, nullptr, false, true, mod, 0, 1024, p.in[I_GPREMIX], (bf16_t*)(ws + O_H));
        } else {
            const int l = (ph - 2) / 9, sp = (ph - 2) % 9;
            unsigned char* wl = ws + l * LAYER_W;
            const float* modl = mod + (size_t)l * 16 * 6144;
            if (sp == 0) {
                SchedInproj S; S.bid = obid(); S.h = (const char*)(ws + O_H); S.win = (const char*)(wl + O_WIN); S.wpq = (const char*)(wl + O_WPQ); S.z = (char*)(ws + O_Z); S.pqt = (char*)(ws + O_PQT);
                S.m1.init(128, 4); S.m2.init(2, 128);
                EpiInproj E; E.ut = (bf16_t*)(ws + O_UT); if (EN(2)) gemm_phase(lds, 1024, 1024, 1024, 1 << 30, 0, S, E);
            } else if (sp == 1) {
                unsigned* ctr = (unsigned*)(ws + O_CTR) + l;
                LAS int* sitem = (LAS int*)(lds + LDS_BYTES - 16);
                for (;;) {
                    __syncthreads();
                    if (otid() == 0) *sitem = (int)atomicAdd(ctr, 1u);
                    __syncthreads();
                    const int item = *sitem;
                    if (item >= 128 + 96 + 512) break;
                    if (item < 128) {
                        const int bb = item >> 3, which = (item >> 2) & 1, jt = item & 3;
                        SchedOne S; S.u0.A = (const char*)(ws + O_DFT) + (size_t)(which * 1024 + jt * 256) * 2048 * 2; S.u0.B = (const char*)(ws + O_PQT) + ((size_t)which * 256 * MTOK + (size_t)bb * 2048) * 2;
                        S.u0.C = (char*)(ws + O_AB) + ((size_t)((which * 16 + bb) * 1024 + jt * 256) * 256) * 4; S.u0.ldc = 256; S.u0.pm = jt; S.u0.pn = bb; S.u0.kind = 1;
                        EpiF32 E; if (EN(3)) gemm_phase(lds, 2048, 2048, MTOK, 1 << 30, 0, S, E);
                    } else if (item < 224) { if (EN(4)) ssm_item(p, lds, l, item - 128); }
                    else { if (EN(5)) attn_item(p, lds, l, item - 224); }
                }
            } else if (sp == 2) {
                {
                    const float* ab = (const float*)(ws + O_AB); bf16_t* yc = (bf16_t*)(ws + O_YCAT);
                    const int gt_ = obid() * NTHREADS + otid();
                    const int gstride = (int)gridDim.x * NTHREADS;
                    for (int idx0 = gt_; idx0 < 16 * 1024 * 64; idx0 += 8 * gstride) {
                        f32x4 av[8], bv[8];
#pragma unroll
                        for (int q = 0; q < 8; ++q) { const int idx = idx0 + q * gstride; const bool ok = idx < 16 * 1024 * 64;
                            const int n4 = (idx & 63) * 4, jj = (idx >> 6) & 1023, bb = ok ? idx >> 16 : 0;
                            av[q] = *(const f32x4*)(ab + ((size_t)(bb * 1024 + jj) * 256 + n4)); bv[q] = *(const f32x4*)(ab + ((size_t)((16 + bb) * 1024 + jj) * 256 + n4)); }
#pragma unroll
                        for (int q = 0; q < 8; ++q) { const int idx = idx0 + q * gstride;
                            if (idx < 16 * 1024 * 64) {
                                const int n4 = (idx & 63) * 4, jj = (idx >> 6) & 1023, bb = idx >> 16, j = jj + 1;
                                const f32x4 a = av[q], b4 = bv[q];
                                u32x2 lo, hi; lo.x = pk_bf16(a[0] - b4[0], a[1] - b4[1]); lo.y = pk_bf16(a[2] - b4[2], a[3] - b4[3]);
                                hi.x = pk_bf16(a[0] + b4[0], a[1] + b4[1]); hi.y = pk_bf16(a[2] + b4[2], a[3] + b4[3]);
                                *(u32x2*)(yc + ((size_t)(bb * 2048 + j) * 1024 + 384 + n4)) = lo;
                                *(u32x2*)(yc + ((size_t)(bb * 2048 + 2048 - j) * 1024 + 384 + n4)) = hi; } }
                    }
                    const bf16_t* pq = (const bf16_t*)(ws + O_PQT);
                    const int lane_ = otid() & 63;
                    for (int w = gt_ >> 6; w < 16 * 256; w += (int)gridDim.x * 8) {
                        const int bb = w >> 8, n = w & 255;
                        const bf16_t* src = pq + (size_t)n * MTOK + (size_t)bb * 2048 + lane_ * 32;
                        float sum = 0.f;
#pragma unroll
                        for (int q = 0; q < 4; ++q) { const u32x4 v = *(const u32x4*)(src + q * 8);
                            sum += (bf_lo(v.x) + bf_hi(v.x)) + (bf_lo(v.y) + bf_hi(v.y)) + (bf_lo(v.z) + bf_hi(v.z)) + (bf_lo(v.w) + bf_hi(v.w)); }
                        sum = wave_sum(sum, lane_);
                        if (lane_ == 0) yc[(size_t)(bb * 2048) * 1024 + 384 + n] = f2bf(sum * 0.02209708691f);
                    }
                }
                SchedPlain S; S.bid = obid(); S.A = (const char*)(ws + O_YPRE); S.B = (const char*)(wl + O_WGLU); S.K = 384; S.total = 256; S.tm.init(128, 2);
                EpiGlu E; E.ypre = (const bf16_t*)(ws + O_YPRE); E.ycat = (bf16_t*)(ws + O_YCAT);
                if (EN(6)) gemm_phase(lds, 384, 384, 384, 1 << 30, 0, S, E);
            } else if (sp == 3) {
                SchedPlain S; S.bid = obid(); S.A = (const char*)(ws + O_YCAT); S.B = (const char*)(wl + O_WOUT); S.K = 1024; S.total = 512; S.tm.init(128, 4);
                EpiY E; E.y = (bf16_t*)(ws + O_Y); E.rss = (float*)(ws + O_RSS);
                if (EN(7)) gemm_phase(lds, 1024, 1024, 1024, 1 << 30, 0, S, E);
            } else if (sp == 4) {
                if (l == 0) phase_rows<false>(p.in[I_X], nullptr, nullptr, (bf16_t*)(ws + O_XB), (const bf16_t*)(ws + O_Y), (const float*)(ws + O_RSS), modl, 2048, p.in[I_GPOSTMIX] + l * 1024, true,
                           true, modl, 3072, 4096, p.in[I_GPREFFN] + l * 1024, (bf16_t*)(ws + O_H));
                else phase_rows<true>(nullptr, (const bf16_t*)(ws + O_XB), nullptr, (bf16_t*)(ws + O_XB), (const bf16_t*)(ws + O_Y), (const float*)(ws + O_RSS), modl, 2048, p.in[I_GPOSTMIX] + l * 1024, true,
                           true, modl, 3072, 4096, p.in[I_GPREFFN] + l * 1024, (bf16_t*)(ws + O_H));
            } else if (sp == 5) {
                SchedPlain S; S.bid = obid(); S.A = (const char*)(ws + O_H); S.B = (const char*)(wl + O_WUP); S.K = 1024; S.total = 128 * 22; S.tm.init(128, 22);
                EpiUp E; E.act = (bf16_t*)(ws + O_ACT); E.edge = (bf16_t*)(ws + O_EDGE); E.cw = p.in[I_CONVW] + (size_t)l * 3 * 5632; E.cb = p.in[I_CONVB] + (size_t)l * 5632;
                if (EN(8)) gemm_phase(lds, 1024, 1024, 1024, 1 << 30, 0, S, E);
            } else if (sp == 6) { if (EN(9)) {
                const bf16_t* edge = (const bf16_t*)(ws + O_EDGE); bf16_t* act = (bf16_t*)(ws + O_ACT);
                const float* cw = p.in[I_CONVW] + (size_t)l * 3 * 5632; const float* cb = p.in[I_CONVB] + (size_t)l * 5632;
                for (int idx = obid() * NTHREADS + otid(); idx < 512 * 2 * 704; idx += gridDim.x * NTHREADS) {
                    const int c4 = (idx % 704) * 4, which = (idx / 704) & 1, seg = idx / 1408;
                    const int t = seg * 64 + (which ? 63 : 0);
                    const bf16_t* ec = edge + (size_t)(seg * 4 + (which ? 3 : 0)) * 2 * DFF;
                    const bf16_t* ep = which ? edge + (size_t)(seg * 4 + 2) * 2 * DFF : ((seg & 31) == 0 ? nullptr : edge + (size_t)((seg - 1) * 4 + 3) * 2 * DFF);
                    const bf16_t* en = which ? ((seg & 31) == 31 ? nullptr : edge + (size_t)((seg + 1) * 4 + 0) * 2 * DFF) : edge + (size_t)(seg * 4 + 1) * 2 * DFF;
                    const u32x2 z2 = {0u, 0u};
                    const u32x2 gpw = ep ? *(const u32x2*)(ep + c4) : z2, gcw = *(const u32x2*)(ec + c4), gnw = en ? *(const u32x2*)(en + c4) : z2;
                    const u32x2 vpw = ep ? *(const u32x2*)(ep + DFF + c4) : z2, vcw = *(const u32x2*)(ec + DFF + c4), vnw = en ? *(const u32x2*)(en + DFF + c4) : z2;
                    const f32x4 wg0 = *(const f32x4*)(cw + c4), wg1 = *(const f32x4*)(cw + 5632 + c4), wg2 = *(const f32x4*)(cw + 2 * 5632 + c4), bg = *(const f32x4*)(cb + c4);
                    const f32x4 wv0 = *(const f32x4*)(cw + 2816 + c4), wv1 = *(const f32x4*)(cw + 5632 + 2816 + c4), wv2 = *(const f32x4*)(cw + 2 * 5632 + 2816 + c4), bv = *(const f32x4*)(cb + 2816 + c4);
                    const f32x4 gp = {bf_lo(gpw.x), bf_hi(gpw.x), bf_lo(gpw.y), bf_hi(gpw.y)}, gc = {bf_lo(gcw.x), bf_hi(gcw.x), bf_lo(gcw.y), bf_hi(gcw.y)}, gn = {bf_lo(gnw.x), bf_hi(gnw.x), bf_lo(gnw.y), bf_hi(gnw.y)};
                    const f32x4 vp = {bf_lo(vpw.x), bf_hi(vpw.x), bf_lo(vpw.y), bf_hi(vpw.y)}, vc = {bf_lo(vcw.x), bf_hi(vcw.x), bf_lo(vcw.y), bf_hi(vcw.y)}, vn = {bf_lo(vnw.x), bf_hi(vnw.x), bf_lo(vnw.y), bf_hi(vnw.y)};
                    const f32x4 ug = wg0 * gp + wg1 * gc + wg2 * gn + bg, uv = wv0 * vp + wv1 * vc + wv2 * vn + bv;
                    float o[4];
#pragma unroll
                    for (int j = 0; j < 4; ++j) o[j] = gelu_tanh(ug[j]) * uv[j];
                    u32x2 w; w.x = pk_bf16(o[0], o[1]); w.y = pk_bf16(o[2], o[3]);
                    *(u32x2*)(act + (size_t)t * DFF + c4) = w;
                } }
            } else if (sp == 7) {
                SchedPlain S; S.bid = obid(); S.A = (const char*)(ws + O_ACT); S.B = (const char*)(wl + O_WDN); S.K = 2816; S.total = 512; S.tm.init(128, 4);
                EpiY E; E.y = (bf16_t*)(ws + O_Y); E.rss = (float*)(ws + O_RSS);
                if (EN(10)) gemm_phase(lds, 2816, 2816, 2816, 1 << 30, 0, S, E);
            } else {
                const bool has_next = (l + 1 < NL);
                const float* modn = mod + (size_t)(l + 1) * 16 * 6144;
                phase_rows<true>(nullptr, (const bf16_t*)(ws + O_XB), p.out, has_next ? (bf16_t*)(ws + O_XB) : nullptr, (const bf16_t*)(ws + O_Y), (const float*)(ws + O_RSS), modl, 5120, p.in[I_GPOSTFFN] + l * 1024, true,
                           has_next, modn, 0, 1024, p.in[I_GPREMIX] + (has_next ? (l + 1) * 1024 : 0), (bf16_t*)(ws + O_H));
            }
        }
        if (ph + 1 < ph_hi) { if (ph_hi < 0) grid.sync();   xcd_barrier((unsigned*)(ws + O_CTR + 1024), xst); }
    }
}

constexpr unsigned ALL_KINDS = 0x7ffu;
extern "C" void kernel_launch(void* const* d_in, const int* in_sizes, int n_in, void* d_out, int out_size, void* d_ws, size_t ws_size, hipStream_t stream) {
    static int grid_blocks = 0;
    if (!grid_blocks) {
        int dev = 0, cus = 0, per_cu = 0;
        (void)hipGetDevice(&dev);
        (void)hipDeviceGetAttribute(&cus, hipDeviceAttributeMultiprocessorCount, dev);
        (void)hipFuncSetAttribute((const void*)fwd_megakernel<ALL_KINDS>, hipFuncAttributeMaxDynamicSharedMemorySize, LDS_BYTES);
        (void)hipOccupancyMaxActiveBlocksPerMultiprocessor(&per_cu, fwd_megakernel<ALL_KINDS>, NTHREADS, LDS_BYTES);
        if (per_cu < 1) per_cu = 1;
        grid_blocks = cus * per_cu;
        if (grid_blocks > 256) grid_blocks = 256;
        if (grid_blocks < 8) grid_blocks = 8;
    }
    Params p{};
    for (int i = 0; i < 25; ++i) p.in[i] = (const float*)d_in[i];
    p.out = (float*)d_out; p.ws = (unsigned char*)d_ws; p.ph_lo = 0; p.ph_hi = NPHASE;
    (void)hipMemsetAsync((unsigned char*)d_ws + O_CTR, 0, 16384, stream);
    void* args[] = {&p};
    hipError_t e = hipLaunchCooperativeKernel((const void*)fwd_megakernel<ALL_KINDS>, dim3(grid_blocks), dim3(NTHREADS), args, LDS_BYTES, stream);
    if (e != hipSuccess) fprintf(stderr, "cooperative launch failed: %s (grid %d)\n", hipGetErrorString(e), grid_blocks);
}
```

```cpp
#include <hip/hip_runtime.h>
#include <hip/hip_cooperative_groups.h>
#include <cstdio>
namespace cg = cooperative_groups;

#define DI __device__ __forceinline__
#define LAS __attribute__((address_space(3)))
typedef unsigned short bf16_t;
typedef short bf16x8 __attribute__((ext_vector_type(8)));
typedef short s16x4 __attribute__((ext_vector_type(4)));
typedef float f32x2 __attribute__((ext_vector_type(2)));
typedef float f32x4 __attribute__((ext_vector_type(4)));
typedef float f32x16 __attribute__((ext_vector_type(16)));
typedef unsigned u32x2 __attribute__((ext_vector_type(2)));
typedef unsigned u32x4 __attribute__((ext_vector_type(4)));
typedef __bf16 nbf16x2 __attribute__((ext_vector_type(2)));

constexpr int MTOK = 32768, DM = 1024, SEQ = 2048, NB = 16, NL = 2, DFF = 2816;
constexpr int BM = 256, BK = 64, HALF = 128, HTB = HALF * BK * 2, STAGE_BYTES = 8 * HTB;
constexpr int LDS_BYTES = 155648;
constexpr int NTHREADS = 512;

constexpr size_t O_WIN = 0;
constexpr size_t O_WPQ = O_WIN + 1024ull * 1024 * 2;
constexpr size_t O_WGLU = O_WPQ + 512ull * 1024 * 2;
constexpr size_t O_WOUT = O_WGLU + 512ull * 384 * 2;
constexpr size_t O_WUP = O_WOUT + 1024ull * 1024 * 2;
constexpr size_t O_WDN = O_WUP + 5632ull * 1024 * 2;
constexpr size_t O_SA = O_WDN + 1024ull * 2816 * 2;
constexpr size_t O_SB = O_SA + 2ull * 24 * 2 * 64 * 4;
constexpr size_t O_SC = O_SB + 2ull * 24 * 4 * 64 * 8 * 2;
constexpr size_t O_CB = O_SC + 2ull * 24 * 8 * 64 * 8 * 2;
constexpr size_t LAYER_W = O_CB + 2ull * 24 * 64 * 8 * 2;
constexpr size_t O_DFT = 2 * LAYER_W;
constexpr size_t O_MOD = O_DFT + 2048ull * 4096 * 2;
constexpr size_t O_CTR = O_MOD + 2ull * 16 * 6144 * 4;
constexpr size_t O_H = O_CTR + 16384;
constexpr size_t O_Y = O_H + (size_t)MTOK * 1024 * 2;
constexpr size_t O_RSS = O_Y + (size_t)MTOK * 1024 * 2;
constexpr size_t O_Z = O_RSS + (size_t)MTOK * 16 * 4;
constexpr size_t O_PQT = O_Z + (size_t)MTOK * 1024 * 2;
constexpr size_t O_YPRE = O_PQT + 512ull * MTOK * 2;
constexpr size_t O_YCAT = O_YPRE + (size_t)MTOK * 384 * 2;
constexpr size_t O_EDGE = O_YCAT + (size_t)MTOK * 1024 * 2;
constexpr size_t O_UT = O_EDGE + 512ull * 4 * 5632 * 2;
constexpr size_t O_XB = O_UT + (size_t)MTOK * 384 * 2;
constexpr size_t O_END = O_XB + (size_t)MTOK * 1024 * 2;
constexpr size_t O_AB = O_H + 2ull * MTOK * 384 * 4;
static_assert(O_AB + 2ull * 16 * 1024 * 256 * 4 <= O_H + 2ull * MTOK * 1024 * 2, "ab alias");
constexpr size_t O_YFB = O_H;
constexpr size_t O_ACT = O_Z;
static_assert(2ull * MTOK * 384 * 4 <= 2ull * MTOK * 1024 * 2, "yfb alias");
static_assert((size_t)MTOK * 2816 * 2 <= O_EDGE - O_Z, "act alias");

struct Params {
    const float* in[25];
    float* out;
    unsigned char* ws;
    int ph_lo, ph_hi;
};
enum { I_X = 0, I_C, I_WADA, I_BADA, I_GPREMIX, I_GPOSTMIX, I_GPREFFN, I_GPOSTFFN, I_WIN, I_LAMRE, I_LAMIM, I_LOGDT, I_BRE, I_BIM, I_CRE, I_CIM,
       I_DSKIP, I_WGLU, I_WFFT, I_SINK, I_WOUT, I_WUP, I_CONVW, I_CONVB, I_WDOWN };

DI unsigned pk_bf16(float lo, float hi) {
    f32x2 v = {lo, hi};
    nbf16x2 b = __builtin_convertvector(v, nbf16x2);
    return __builtin_bit_cast(unsigned, b);
}
DI float bf_lo(unsigned w) { return __uint_as_float(w << 16); }
DI float bf_hi(unsigned w) { return __uint_as_float(w & 0xffff0000u); }
DI float bf2f(bf16_t b) { return __uint_as_float(((unsigned)b) << 16); }
DI bf16_t f2bf(float f) { return (bf16_t)(pk_bf16(f, 0.f) & 0xffffu); }
DI float gelu_tanh(float x) {
    float t = x * (1.0f + 0.044715f * x * x);
    float e = __builtin_amdgcn_exp2f(-2.302208198f * t);
    return x * __builtin_amdgcn_rcpf(1.0f + e);
}
DI float sigmoidf_(float x) { return __builtin_amdgcn_rcpf(1.0f + __builtin_amdgcn_exp2f(-1.442695041f * x)); }
DI bf16x8 pack8(float a0, float a1, float a2, float a3, float a4, float a5, float a6, float a7) {
    u32x4 w; w.x = pk_bf16(a0, a1); w.y = pk_bf16(a2, a3); w.z = pk_bf16(a4, a5); w.w = pk_bf16(a6, a7);
    return __builtin_bit_cast(bf16x8, w);
}
DI int otid() { int t = threadIdx.x; asm volatile("" : "+v"(t)); return t; }
DI int obid() { int b = blockIdx.x; asm volatile("" : "+s"(b)); return b; }
DI float bperm(float v, int srclane) { return __int_as_float(__builtin_amdgcn_ds_bpermute(srclane << 2, __float_as_int(v))); }
#define MFMA32(a, b, c) __builtin_amdgcn_mfma_f32_32x32x16_bf16((a), (b), (c), 0, 0, 0)

DI int lds_byte(int r, int c) { const int st = (r >> 4) * 2 + (c >> 5), rr = r & 15, cc = c & 31, ob = rr * 64 + cc * 2; return st * 1024 + (ob ^ (((ob >> 9) & 1) << 5)); }
DI void stage_rc(int b, int& R, int& C) { const int st = b / 1024, sb = b % 1024, swz = sb ^ (((sb >> 9) & 1) << 5); R = (st >> 1) * 16 + swz / 64; C = (st & 1) * 32 + (swz % 64) / 2; }
DI int perm32(int rho) { const int n = rho >> 4, i = rho & 15; return 8 * (i >> 2) + 4 * n + (i & 3); }

struct Unit { const char* A; const char* B; char* C; int ldc; int pm, pn; int kind; };
struct TileMap {
    int nM, nN, nwg;
    DI void init(int nM_, int nN_) { nM = nM_; nN = nN_; nwg = nM_ * nN_; }
    DI void get(int L, int& pm, int& pn) const {
        int wgid = L; { const int q = nwg / 8, r = nwg % 8, xcd = wgid % 8, off = wgid / 8; wgid = (xcd < r ? xcd * (q + 1) : r * (q + 1) + (xcd - r) * q) + off; }
        const int nig = 8 * nN, gid = wgid / nig, fm = gid * 8, gsz = (nM - fm) < 8 ? (nM - fm) : 8;
        pm = fm + ((wgid % nig) % gsz); pn = (wgid % nig) / gsz;
    }
};

template <class Epi, class Sched>
DI void gemm_phase(LAS unsigned char* lds, const int K, const int lda, const int ldb, const int jt, const long jumpB, Sched& S, const Epi& E) {
    const int tid = otid(), wid = __builtin_amdgcn_readfirstlane(tid >> 6), lane = tid & 63, wr = wid >> 2, wc = wid & 3, fr = lane & 15, fq = lane >> 4;
    const int nt = K / BK;
    unsigned voffA[2], voffB[2];
#pragma unroll
    for (int i = 0; i < 2; ++i) { int R, C; stage_rc(tid * 16 + i * 8192, R, C); const int Rb = (R >> 5) * 64 + perm32(R & 31);
        const int Ra = Epi::APERM ? ((R & ~63) + 4 * (R & 15) + ((R >> 4) & 3)) : R;
        voffA[i] = (unsigned)(Ra * lda + C) * 2u; voffB[i] = (unsigned)(Rb * ldb + C) * 2u; }
    const size_t kstep = (size_t)(BK * 2);
    const size_t hstepA = (size_t)HALF * lda * 2, hstepB = (size_t)32 * ldb * 2;
    const unsigned ldsw = (unsigned)wid * 1024u;
    const int aoff = lds_byte(wr * 64 + fr, fq * 8), boff = lds_byte(wc * 32 + fr, fq * 8);
#define PG8_SA(b, h) (((b) * 2 + (h)) * HTB)
#define PG8_SB(b, h) ((4 + (b) * 2 + (h)) * HTB)
#define PG8_STAGE(bufoff, gbase, voff) do { _Pragma("unroll") for (int _i = 0; _i < 2; ++_i) \
        __builtin_amdgcn_global_load_lds((const unsigned*)((const char*)(gbase) + (voff)[_i]), (LAS unsigned*)(lds + (bufoff) + ldsw + _i * 8192), 16, 0, 0); } while (0)
#define PG8_LDA(dst, b, h) do { _Pragma("unroll") for (int m = 0; m < 4; ++m) _Pragma("unroll") for (int k = 0; k < 2; ++k) dst[m][k] = *(const LAS bf16x8*)(lds + PG8_SA(b, h) + aoff + m * 2048 + k * 1024); } while (0)
#define PG8_LDB(dst, b, h) do { _Pragma("unroll") for (int n = 0; n < 2; ++n) _Pragma("unroll") for (int k = 0; k < 2; ++k) dst[n][k] = *(const LAS bf16x8*)(lds + PG8_SB(b, h) + boff + n * 2048 + k * 1024); } while (0)
#define PG8_MMA(ai, bj, At, Bt) do { __builtin_amdgcn_s_setprio(1); _Pragma("unroll") for (int m = 0; m < 4; ++m) _Pragma("unroll") for (int n = 0; n < 2; ++n) _Pragma("unroll") for (int k = 0; k < 2; ++k) \
        acc[ai][bj][m][n] = __builtin_amdgcn_mfma_f32_16x16x32_bf16(Bt[n][k], At[m][k], acc[ai][bj][m][n], 0, 0, 0); __builtin_amdgcn_s_setprio(0); } while (0)
#define PG8_WAIT_V(n) asm volatile("s_waitcnt vmcnt(" #n ")" ::: "memory")
#define PG8_WAIT_L(n) asm volatile("s_waitcnt lgkmcnt(" #n ")" ::: "memory")
#define PG8_BAR __builtin_amdgcn_s_barrier()
#define PG8_SCHED __builtin_amdgcn_sched_barrier(0)
    Unit cur, nxt; int ui = 0;
    if (!S.next(0, cur)) return;
    f32x4 acc[2][2][4][2];
#pragma unroll
    for (int a = 0; a < 2; ++a)
#pragma unroll
        for (int b = 0; b < 2; ++b)
#pragma unroll
            for (int m = 0; m < 4; ++m)
#pragma unroll
                for (int n = 0; n < 2; ++n) acc[a][b][m][n] = (f32x4){0.f, 0.f, 0.f, 0.f};
    bf16x8 At[4][2], B0[2][2], B1[2][2];
    const char* cA = cur.A; const char* cB = cur.B;
    E.begin(cur, lds);
    PG8_STAGE(PG8_SB(0, 0), cB, voffB); PG8_STAGE(PG8_SA(0, 0), cA, voffA); PG8_STAGE(PG8_SB(0, 1), cB + hstepB, voffB); PG8_STAGE(PG8_SA(0, 1), cA + hstepA, voffA);
    if (wr == 1) PG8_BAR;
    PG8_WAIT_V(4); PG8_BAR;
    PG8_STAGE(PG8_SB(1, 0), cB + kstep, voffB); PG8_STAGE(PG8_SA(1, 0), cA + kstep, voffA); PG8_STAGE(PG8_SB(1, 1), cB + hstepB + kstep, voffB);
    PG8_WAIT_V(6); PG8_BAR;
    for (;;) {
        const bool has_next = S.next(ui + 1, nxt);
        const char* nA = has_next ? nxt.A : cA; const char* nB = has_next ? nxt.B : cB;
#pragma unroll 1
        for (int t = 0; t < nt; t += 2) {
            const bool last = (t == nt - 2);
            const char* a1 = cA + (size_t)(t + 1) * kstep;
            const char* a2 = last ? nA : cA + (size_t)(t + 2) * kstep;
            const char* b2 = last ? nB : cB + (size_t)(t + 2) * kstep + ((t + 2) >= jt ? jumpB : 0);
            const char* a3 = a2 + kstep; const char* b3 = b2 + kstep;
            PG8_LDB(B0, 0, 0); PG8_SCHED; PG8_LDA(At, 0, 0); PG8_STAGE(PG8_SA(1, 1), a1 + hstepA, voffA);
            PG8_WAIT_L(8); PG8_BAR; PG8_WAIT_L(0); PG8_MMA(0, 0, At, B0); PG8_BAR; PG8_SCHED;
            PG8_LDB(B1, 0, 1); PG8_STAGE(PG8_SB(0, 0), b2, voffB);
            PG8_BAR; PG8_WAIT_L(0); PG8_MMA(0, 1, At, B1); PG8_BAR;
            PG8_LDA(At, 0, 1); PG8_STAGE(PG8_SA(0, 0), a2, voffA);
            PG8_BAR; PG8_WAIT_L(0); PG8_MMA(1, 0, At, B0); PG8_BAR; PG8_SCHED;
            PG8_STAGE(PG8_SB(0, 1), b2 + hstepB, voffB);
            PG8_WAIT_V(6); PG8_BAR; PG8_MMA(1, 1, At, B1); PG8_BAR;
            PG8_LDB(B0, 1, 0); PG8_SCHED; PG8_LDA(At, 1, 0); PG8_STAGE(PG8_SA(0, 1), a2 + hstepA, voffA);
            PG8_WAIT_L(8); PG8_BAR; PG8_WAIT_L(0); PG8_MMA(0, 0, At, B0); PG8_BAR; PG8_SCHED;
            PG8_LDB(B1, 1, 1); PG8_STAGE(PG8_SB(1, 0), b3, voffB);
            PG8_BAR; PG8_WAIT_L(0); PG8_MMA(0, 1, At, B1); PG8_BAR;
            PG8_LDA(At, 1, 1); PG8_STAGE(PG8_SA(1, 0), a3, voffA);
            PG8_BAR; PG8_WAIT_L(0); PG8_MMA(1, 0, At, B0); PG8_BAR; PG8_SCHED;
            PG8_STAGE(PG8_SB(1, 1), b3 + hstepB, voffB);
            PG8_WAIT_V(6); PG8_BAR; PG8_MMA(1, 1, At, B1); PG8_BAR;
        }
        E(acc, cur, nxt, has_next, ui, lds, wr, wc);
        if (!has_next) break;
#pragma unroll
        for (int a = 0; a < 2; ++a)
#pragma unroll
            for (int b = 0; b < 2; ++b)
#pragma unroll
                for (int m = 0; m < 4; ++m)
#pragma unroll
                    for (int n = 0; n < 2; ++n) acc[a][b][m][n] = (f32x4){0.f, 0.f, 0.f, 0.f};
        cur = nxt; cA = nA; cB = nB; ++ui;
    }
    PG8_WAIT_V(0);
    if (wr == 0) PG8_BAR;
    PG8_BAR;
#undef PG8_SA
#undef PG8_SB
#undef PG8_STAGE
#undef PG8_LDA
#undef PG8_LDB
#undef PG8_MMA
#undef PG8_WAIT_V
#undef PG8_WAIT_L
#undef PG8_BAR
#undef PG8_SCHED
}

typedef f32x4 Acc[2][2][4][2];
DI int opaque_lane() { int l; asm volatile("v_mbcnt_lo_u32_b32 %0, -1, 0\n\tv_mbcnt_hi_u32_b32 %0, -1, %0" : "=v"(l)); return l; }
struct EpiBf16 {
    static constexpr bool APERM = false;
    DI void begin(const Unit&, LAS unsigned char*) const {}
    DI void operator()(Acc& acc, const Unit& u, const Unit&, bool, int, LAS unsigned char*, int wr, int wc) const {
        const int lane_ = opaque_lane(), fr = lane_ & 15, fq = lane_ >> 4;
        bf16_t* base = (bf16_t*)u.C + (size_t)(wr * 64 + fr) * u.ldc + wc * 64 + 8 * fq;
#pragma unroll
        for (int ai = 0; ai < 2; ++ai)
#pragma unroll
            for (int m = 0; m < 4; ++m) { bf16_t* rowp = base + (size_t)(ai * HALF + m * 16) * u.ldc;
#pragma unroll
                for (int bj = 0; bj < 2; ++bj) { const f32x4 v0 = acc[ai][bj][m][0], v1 = acc[ai][bj][m][1];
                    u32x4 w; w.x = pk_bf16(v0[0], v0[1]); w.y = pk_bf16(v0[2], v0[3]); w.z = pk_bf16(v1[0], v1[1]); w.w = pk_bf16(v1[2], v1[3]);
                    __builtin_nontemporal_store(w, (u32x4*)(rowp + bj * 32)); } }
    }
};
struct EpiInproj {
    static constexpr bool APERM = false;
    bf16_t* ut;
    DI void begin(const Unit&, LAS unsigned char*) const {}
    DI void operator()(Acc& acc, const Unit& u, const Unit&, bool, int, LAS unsigned char*, int wr, int wc) const {
        const int lane_ = opaque_lane(), fr = lane_ & 15, fq = lane_ >> 4;
        bf16_t* base = (bf16_t*)u.C + (size_t)(wr * 64 + fr) * u.ldc + wc * 64 + 8 * fq;
#pragma unroll
        for (int ai = 0; ai < 2; ++ai)
#pragma unroll
            for (int m = 0; m < 4; ++m) { bf16_t* rowp = base + (size_t)(ai * HALF + m * 16) * u.ldc;
#pragma unroll
                for (int bj = 0; bj < 2; ++bj) { const f32x4 v0 = acc[ai][bj][m][0], v1 = acc[ai][bj][m][1];
                    u32x4 w; w.x = pk_bf16(v0[0], v0[1]); w.y = pk_bf16(v0[2], v0[3]); w.z = pk_bf16(v1[0], v1[1]); w.w = pk_bf16(v1[2], v1[3]);
                    if (u.kind == 0 && u.pn * BM + wc * 64 < 384) {
                        const int col = u.pn * BM + wc * 64 + bj * 32 + 8 * fq, t = u.pm * BM + ai * HALF + wr * 64 + m * 16 + fr;
                        const unsigned o = (unsigned)((((((t >> 11) * 24 + (col >> 4)) * 64 + (t & 63)) * 32 + ((t >> 6) & 31)) * 16) + (col & 8));
                        *(u32x4*)(ut + o) = w;
                    } else __builtin_nontemporal_store(w, (u32x4*)(rowp + bj * 32)); } }
    }
};
struct EpiF32 {
    static constexpr bool APERM = false;
    DI void begin(const Unit&, LAS unsigned char*) const {}
    DI void operator()(Acc& acc, const Unit& u, const Unit&, bool, int, LAS unsigned char*, int wr, int wc) const {
        const int lane_ = opaque_lane(), fr = lane_ & 15, fq = lane_ >> 4;
        float* base = (float*)u.C + (size_t)(wr * 64 + fr) * u.ldc + wc * 64 + 8 * fq;
#pragma unroll
        for (int ai = 0; ai < 2; ++ai)
#pragma unroll
            for (int m = 0; m < 4; ++m) { float* rowp = base + (size_t)(ai * HALF + m * 16) * u.ldc;
#pragma unroll
                for (int bj = 0; bj < 2; ++bj) { *(f32x4*)(rowp + bj * 32) = acc[ai][bj][m][0]; *(f32x4*)(rowp + bj * 32 + 4) = acc[ai][bj][m][1]; } }
    }
};
struct EpiGlu {
    static constexpr bool APERM = false;
    const bf16_t* ypre; bf16_t* ycat;
    DI void begin(const Unit&, LAS unsigned char*) const {}
    DI void operator()(Acc& acc, const Unit& u, const Unit&, bool, int, LAS unsigned char*, int wr, int wc) const {
        if (u.pn * BM + wc * 64 >= 384) return;
#pragma unroll
        for (int ai = 0; ai < 2; ++ai)
#pragma unroll
            for (int bj = 0; bj < 2; ++bj)
#pragma unroll
                for (int m = 0; m < 4; ++m)
#pragma unroll
                    for (int n = 0; n < 2; ++n)
#pragma unroll
                        for (int j = 0; j < 4; ++j) acc[ai][bj][m][n][j] = sigmoidf_(acc[ai][bj][m][n][j]);
#pragma unroll
        for (int bj = 0; bj < 2; ++bj) {
            if (u.pn * BM + wc * 64 < 384) {
#pragma unroll
                for (int ai = 0; ai < 2; ++ai)
#pragma unroll
                    for (int m = 0; m < 4; ++m) {
                        const int lane_ = opaque_lane(), fr = lane_ & 15, fq = lane_ >> 4;
                        const unsigned row = (unsigned)(u.pm * BM + wr * 64 + fr + ai * HALF + m * 16), col = (unsigned)(u.pn * BM + wc * 64 + 8 * fq + bj * 32);
                        const u32x4 yp = *(const u32x4*)(ypre + (row * 384u + col));
                        const f32x4 v0 = acc[ai][bj][m][0], v1 = acc[ai][bj][m][1];
                        u32x4 w;
                        w.x = pk_bf16(bf_lo(yp.x) * v0[0], bf_hi(yp.x) * v0[1]);
                        w.y = pk_bf16(bf_lo(yp.y) * v0[2], bf_hi(yp.y) * v0[3]);
                        w.z = pk_bf16(bf_lo(yp.z) * v1[0], bf_hi(yp.z) * v1[1]);
                        w.w = pk_bf16(bf_lo(yp.w) * v1[2], bf_hi(yp.w) * v1[3]);
                        *(u32x4*)(ycat + (row * 1024u + col)) = w;
                    }
            }
        }
    }
};
struct EpiY {
    static constexpr bool APERM = false;
    bf16_t* y; float* rss;
    DI void begin(const Unit&, LAS unsigned char*) const {}
    DI void operator()(Acc& acc, const Unit& u, const Unit&, bool, int, LAS unsigned char*, int wr, int wc) const {
        const int lane_ = opaque_lane(), fr = lane_ & 15, fq = lane_ >> 4;
        const int row0 = u.pm * BM + wr * 64 + fr, col0 = u.pn * BM + wc * 64 + 8 * fq;
#pragma unroll
        for (int ai = 0; ai < 2; ++ai)
#pragma unroll
            for (int m = 0; m < 4; ++m) { const size_t row = (size_t)(row0 + ai * HALF + m * 16); float s = 0.f;
#pragma unroll
                for (int bj = 0; bj < 2; ++bj) { const f32x4 v0 = acc[ai][bj][m][0], v1 = acc[ai][bj][m][1];
                    s += (v0[0] * v0[0] + v0[1] * v0[1]) + (v0[2] * v0[2] + v0[3] * v0[3]) + (v1[0] * v1[0] + v1[1] * v1[1]) + (v1[2] * v1[2] + v1[3] * v1[3]);
                    u32x4 w; w.x = pk_bf16(v0[0], v0[1]); w.y = pk_bf16(v0[2], v0[3]); w.z = pk_bf16(v1[0], v1[1]); w.w = pk_bf16(v1[2], v1[3]);
                    __builtin_nontemporal_store(w, (u32x4*)(y + row * 1024 + col0 + bj * 32)); }
                s += bperm(s, lane_ ^ 16); s += bperm(s, lane_ ^ 32);
                if (fq == 0) rss[row * 16 + u.pn * 4 + wc] = s; }
    }
};
DI float dpp_prev(float cur, float prevreg) {
    const int t = __builtin_amdgcn_update_dpp(0, __float_as_int(prevreg), 0x121, 0xf, 0xf, false);
    return __int_as_float(__builtin_amdgcn_update_dpp(t, __float_as_int(cur), 0x111, 0xf, 0xf, false));
}
DI float dpp_next(float cur, float nextreg) {
    const int t = __builtin_amdgcn_update_dpp(0, __float_as_int(nextreg), 0x12f, 0xf, 0xf, false);
    return __int_as_float(__builtin_amdgcn_update_dpp(t, __float_as_int(cur), 0x101, 0xf, 0xf, false));
}
DI f32x4 dpp_shr1_v(const f32x4 v) { f32x4 r;
#pragma unroll
    for (int j = 0; j < 4; ++j) r[j] = __int_as_float(__builtin_amdgcn_update_dpp(__float_as_int(v[j]), __float_as_int(v[j]), 0x111, 0xf, 0xf, false));
    return r; }
DI f32x4 dpp_shl1_v(const f32x4 v) { f32x4 r;
#pragma unroll
    for (int j = 0; j < 4; ++j) r[j] = __int_as_float(__builtin_amdgcn_update_dpp(__float_as_int(v[j]), __float_as_int(v[j]), 0x101, 0xf, 0xf, false));
    return r; }
struct EpiUp {
    static constexpr bool APERM = true;
    bf16_t* act; bf16_t* edge; const float* cw; const float* cb;
    DI float ldw(const Unit& u, int idx) const { const int arr = idx >> 8, col = idx & 255, chn = (col >> 7) * 2816 + u.pn * 128 + (col & 127); return arr < 3 ? cw[arr * 5632 + chn] : cb[chn]; }
    DI void begin(const Unit& u, LAS unsigned char* lds) const {
        const int t = otid(); LAS float* wb = (LAS float*)(lds + STAGE_BYTES);
        wb[t] = ldw(u, t); wb[t + 512] = ldw(u, t + 512);
    }
    DI void operator()(Acc& acc, const Unit& u, const Unit& nx, bool has_next, int ui, LAS unsigned char* lds, int wr, int wc) const {
        const int t_ = otid();
        float pa = 0.f, pb = 0.f;
        if (has_next) { pa = ldw(nx, t_); pb = ldw(nx, t_ + 512); }
        const LAS float* wb = (const LAS float*)(lds + STAGE_BYTES) + (ui & 1) * 1024;
        {
            const int l_ = opaque_lane(), fr = l_ & 15, ch0 = u.pn * 128 + wc * 32 + 8 * (l_ >> 4);
            if (fr == 0 || fr == 15) {
                const int slot0 = fr == 0 ? 0 : 2;
#pragma unroll
                for (int ai = 0; ai < 2; ++ai) { const int seg = u.pm * 4 + ai * 2 + wr;
#pragma unroll
                    for (int bj = 0; bj < 2; ++bj)
#pragma unroll
                        for (int n = 0; n < 2; ++n) {
                            const f32x4 a = fr == 0 ? acc[ai][bj][0][n] : acc[ai][bj][2][n], b = fr == 0 ? acc[ai][bj][1][n] : acc[ai][bj][3][n];
                            u32x2 g2; g2.x = pk_bf16(a[0], a[1]); g2.y = pk_bf16(a[2], a[3]);
                            u32x2 h2; h2.x = pk_bf16(b[0], b[1]); h2.y = pk_bf16(b[2], b[3]);
                            *(u32x2*)(edge + (unsigned)(((seg * 4 + slot0) * 2 + bj) * DFF + ch0 + 4 * n)) = g2;
                            *(u32x2*)(edge + (unsigned)(((seg * 4 + slot0 + 1) * 2 + bj) * DFF + ch0 + 4 * n)) = h2; } }
            }
        }
#pragma unroll
        for (int bj = 0; bj < 2; ++bj)
#pragma unroll
            for (int n = 0; n < 2; ++n) {
                const int l_ = opaque_lane();
                const int wi = bj * 128 + wc * 32 + 8 * (l_ >> 4) + 4 * n;
                const f32x4 w0 = *(const LAS f32x4*)(wb + wi), w1 = *(const LAS f32x4*)(wb + 256 + wi), w2 = *(const LAS f32x4*)(wb + 512 + wi), bb = *(const LAS f32x4*)(wb + 768 + wi);
#pragma unroll
                for (int ai = 0; ai < 2; ++ai) {
                    const f32x4 X0 = acc[ai][bj][0][n], X1 = acc[ai][bj][1][n], X2 = acc[ai][bj][2][n], X3 = acc[ai][bj][3][n];
                    const f32x4 P = dpp_shr1_v(X3), N = dpp_shl1_v(X0);
                    f32x4 Y0 = w0 * P + w1 * X0 + w2 * X1 + bb, Y1 = w0 * X0 + w1 * X1 + w2 * X2 + bb, Y2 = w0 * X1 + w1 * X2 + w2 * X3 + bb, Y3 = w0 * X2 + w1 * X3 + w2 * N + bb;
                    if (bj == 0) {
#pragma unroll
                        for (int j = 0; j < 4; ++j) { Y0[j] = gelu_tanh(Y0[j]); Y1[j] = gelu_tanh(Y1[j]); Y2[j] = gelu_tanh(Y2[j]); Y3[j] = gelu_tanh(Y3[j]); }
                    }
                    acc[ai][bj][0][n] = Y0; acc[ai][bj][1][n] = Y1; acc[ai][bj][2][n] = Y2; acc[ai][bj][3][n] = Y3;
                }
                asm volatile("" ::: "memory");
            }
        {
            const int l_ = opaque_lane(), fr = l_ & 15, ch0 = u.pn * 128 + wc * 32 + 8 * (l_ >> 4);
#pragma unroll
            for (int ai = 0; ai < 2; ++ai)
#pragma unroll
                for (int m = 0; m < 4; ++m) {
                    const unsigned row = (unsigned)(u.pm * BM + ai * HALF + wr * 64 + 4 * fr + m);
                    const f32x4 g0 = acc[ai][0][m][0], v0 = acc[ai][1][m][0], g1 = acc[ai][0][m][1], v1 = acc[ai][1][m][1];
                    u32x4 w; w.x = pk_bf16(g0[0] * v0[0], g0[1] * v0[1]); w.y = pk_bf16(g0[2] * v0[2], g0[3] * v0[3]);
                    w.z = pk_bf16(g1[0] * v1[0], g1[1] * v1[1]); w.w = pk_bf16(g1[2] * v1[2], g1[3] * v1[3]);
                    __builtin_nontemporal_store(w, (u32x4*)(act + (row * (unsigned)DFF + (unsigned)ch0)));
                }
        }
        if (has_next) { LAS float* wn = (LAS float*)(lds + STAGE_BYTES) + ((ui + 1) & 1) * 1024; wn[t_] = pa; wn[t_ + 512] = pb; }
    }
};

struct SchedInproj {
    const char* h; const char* win; const char* wpq; char* z; char* pqt; TileMap m1, m2; int bid;
    DI bool next(int i, Unit& u) const {
        const int L = i * (int)gridDim.x + bid; if (L >= 768) return false;
        int pm, pn;
        if (L < 512) { m1.get(L, pm, pn); u.A = h + (size_t)pm * 256 * 1024 * 2; u.B = win + (size_t)pn * 256 * 1024 * 2; u.C = z + ((size_t)pm * 256 * 1024 + pn * 256) * 2; u.ldc = 1024; u.kind = 0; }
        else { m2.get(L - 512, pm, pn); u.A = wpq + (size_t)pm * 256 * 1024 * 2; u.B = h + (size_t)pn * 256 * 1024 * 2; u.C = pqt + ((size_t)pm * 256 * MTOK + pn * 256) * 2; u.ldc = MTOK; u.kind = 1; }
        u.pm = pm; u.pn = pn; return true;
    }
};
struct SchedPlain {
    const char* A; const char* B; int K; int total; TileMap tm; int bid;
    DI bool next(int i, Unit& u) const {
        const int L = i * (int)gridDim.x + bid; if (L >= total) return false;
        int pm, pn; tm.get(L, pm, pn);
        u.A = A + (size_t)pm * 256 * K * 2; u.B = B + (size_t)pn * 256 * K * 2; u.C = nullptr; u.ldc = 0; u.pm = pm; u.pn = pn; u.kind = 0; return true;
    }
};
struct SchedOne { Unit u0; DI bool next(int i, Unit& u) const { if (i > 0) return false; u = u0; return true; } };

DI void tconv_tile(LAS float* tile, const float* src, int ld_src, int k0, int srccol, bf16_t* dst, int ldd, int n0, int srccol_hi = -2) {
    const int tid = otid();
    __syncthreads();
#pragma unroll
    for (int i = 0; i < 8; ++i) { const int k = (tid >> 6) + 8 * i, n = tid & 63;
        const int sc2 = (srccol_hi != -2 && n >= 32) ? srccol_hi + (n - 32) : srccol + n;
        tile[k * 65 + n] = srccol >= 0 ? src[(size_t)(k0 + k) * ld_src + sc2] : 0.f; }
    __syncthreads();
    const int n = tid >> 3, kc = (tid & 7) * 8;
    float v[8];
#pragma unroll
    for (int j = 0; j < 8; ++j) v[j] = tile[(kc + j) * 65 + n];
    u32x4 w; w.x = pk_bf16(v[0], v[1]); w.y = pk_bf16(v[2], v[3]); w.z = pk_bf16(v[4], v[5]); w.w = pk_bf16(v[6], v[7]);
    *(u32x4*)(dst + (size_t)(n0 + n) * ldd + k0 + kc) = w;
}

DI void phase_prep(const Params& p, LAS unsigned char* lds) {
    const int tid = otid(), nblk = gridDim.x, bid = obid();
    LAS float* tile = (LAS float*)lds;
    for (int l = 0; l < NL; ++l) {
        unsigned char* wl = p.ws + l * LAYER_W;
        const float* w_in = p.in[I_WIN] + (size_t)l * 1024 * 1280;
        const float* w_glu = p.in[I_WGLU] + (size_t)l * 384 * 384;
        const float* w_out = p.in[I_WOUT] + (size_t)l * 1024 * 1024;
        const float* w_up = p.in[I_WUP] + (size_t)l * 1024 * 5632;
        const float* w_dn = p.in[I_WDOWN] + (size_t)l * 2816 * 1024;
        const float* w_fft = p.in[I_WFFT] + (size_t)l * 4 * 64 * 64;
        for (int j = bid; j < 2608; j += nblk) {
            if (j < 256) { const int kc = j >> 4, nc = j & 15; tconv_tile(tile, w_in, 1280, kc * 64, (nc < 6 ? nc : nc + 4) * 64, (bf16_t*)(wl + O_WIN), 1024, nc * 64); }
            else if (j < 304) { const int q = j - 256, kc = q >> 3, nc = q & 7; tconv_tile(tile, w_glu, 384, kc * 64, nc < 6 ? nc * 64 : -1, (bf16_t*)(wl + O_WGLU), 384, nc * 64); }
            else if (j < 496) { const int q = j - 304; int kc = q >> 4; const int nc = q & 15; kc = kc < 6 ? kc : kc + 4; tconv_tile(tile, w_out, 1024, kc * 64, nc * 64, (bf16_t*)(wl + O_WOUT), 1024, nc * 64); }
            else if (j < 1904) { const int q = j - 496, kc = q / 88, nc = q % 88, pn = nc >> 2, w4 = nc & 3;
                tconv_tile(tile, w_up, 5632, kc * 64, pn * 128 + w4 * 32, (bf16_t*)(wl + O_WUP), 1024, nc * 64, 2816 + pn * 128 + w4 * 32); }
            else { const int q = j - 1904, kc = q >> 4, nc = q & 15; tconv_tile(tile, w_dn, 1024, kc * 64, nc * 64, (bf16_t*)(wl + O_WDN), 2816, nc * 64); }
        }
        for (int j = (bid + nblk - 64 - 128 * l) % nblk; j < 64; j += nblk) {
            const int kc = j >> 2, hh = j & 3;
            __syncthreads();
#pragma unroll
            for (int i = 0; i < 8; ++i) { const int k = (tid >> 6) + 8 * i, d = tid & 63; tile[k * 65 + d] = w_in[(size_t)(kc * 64 + k) * 1280 + 384 + hh * 64 + d]; }
            LAS float* tab = tile + 64 * 65;
            if (tid < 64) { float s, c; sincospif((float)tid / 32.0f, &s, &c); tab[tid] = c * 0.125f; tab[64 + tid] = s * 0.125f; }
            __syncthreads();
            const int r = tid >> 2, part = r >> 6, e = r & 63, kg = (tid & 3) * 16;
            float o[16];
#pragma unroll
            for (int q = 0; q < 16; ++q) o[q] = 0.f;
            for (int d = 0; d < 64; ++d) { const float tv = tab[part * 64 + ((d * e) & 63)];
#pragma unroll
                for (int q = 0; q < 16; ++q) o[q] += tile[(kg + q) * 65 + d] * tv; }
            bf16_t* dst = (bf16_t*)(wl + O_WPQ) + (size_t)(part * 256 + hh * 64 + e) * 1024 + kc * 64 + kg;
            u32x4 w0, w1; w0.x = pk_bf16(o[0], o[1]); w0.y = pk_bf16(o[2], o[3]); w0.z = pk_bf16(o[4], o[5]); w0.w = pk_bf16(o[6], o[7]);
            w1.x = pk_bf16(o[8], o[9]); w1.y = pk_bf16(o[10], o[11]); w1.z = pk_bf16(o[12], o[13]); w1.w = pk_bf16(o[14], o[15]);
            *(u32x4*)dst = w0; *(u32x4*)(dst + 8) = w1;
        }
        for (int j = (bid + nblk - 128 - 128 * l + 2 * nblk) % nblk; j < 64; j += nblk) {
            const int hh = j >> 4, nc = j & 15;
            LAS float* tf = tile + 64 * 65;
            __syncthreads();
#pragma unroll
            for (int i = 0; i < 8; ++i) { const int e = (tid >> 6) + 8 * i, n = tid & 63;
                tile[e * 65 + n] = w_out[(size_t)(384 + hh * 64 + e) * 1024 + nc * 64 + n];
                tf[e * 65 + n] = w_fft[(size_t)hh * 4096 + e * 64 + n]; }
            __syncthreads();
            const int n = tid >> 3, dg = (tid & 7) * 8;
            float o[8];
#pragma unroll
            for (int q = 0; q < 8; ++q) o[q] = 0.f;
            for (int e = 0; e < 64; ++e) { const float wv = tile[e * 65 + n];
#pragma unroll
                for (int q = 0; q < 8; ++q) o[q] += tf[(dg + q) * 65 + e] * wv; }
            u32x4 w; w.x = pk_bf16(o[0], o[1]); w.y = pk_bf16(o[2], o[3]); w.z = pk_bf16(o[4], o[5]); w.w = pk_bf16(o[6], o[7]);
            *(u32x4*)((bf16_t*)(wl + O_WOUT) + (size_t)(nc * 64 + n) * 1024 + 384 + hh * 64 + dg) = w;
        }
        {
            const float* lam_re = p.in[I_LAMRE] + (size_t)l * 2 * 24 * 64; const float* lam_im = p.in[I_LAMIM] + (size_t)l * 2 * 24 * 64;
            const float* log_dt = p.in[I_LOGDT] + (size_t)l * 2 * 24;
            const float* b_re = p.in[I_BRE] + (size_t)l * 2 * 24 * 64 * 16; const float* b_im = p.in[I_BIM] + (size_t)l * 2 * 24 * 64 * 16;
            const float* c_re = p.in[I_CRE] + (size_t)l * 24 * 16 * 64; const float* c_im = p.in[I_CIM] + (size_t)l * 24 * 16 * 64;
            float* sa = (float*)(wl + O_SA); bf16_t* sb = (bf16_t*)(wl + O_SB); bf16_t* sc = (bf16_t*)(wl + O_SC);
            for (int idx = bid * NTHREADS + tid; idx < 2 * 24 * 64; idx += nblk * NTHREADS) {
                const int pp = idx & 63, g = (idx >> 6) % 24, dir = idx / (64 * 24);
                const float lr = lam_re[idx], li = lam_im[idx], dt = expf(log_dt[dir * 24 + g]);
                const float mag = expf(lr * dt); float sn, cs; sincosf(li * dt, &sn, &cs);
                const float ar = mag * cs, ai = mag * sn;
                sa[((dir * 24 + g) * 2 + 0) * 64 + pp] = ar; sa[((dir * 24 + g) * 2 + 1) * 64 + pp] = ai;
                const float xr = ar - 1.0f, xi = ai, den = 1.0f / (lr * lr + li * li);
                const float fr_ = (xr * lr + xi * li) * den, fi_ = (xi * lr - xr * li) * den;
                for (int ch = 0; ch < 16; ++ch) {
                    const float br = b_re[(size_t)idx * 16 + ch], bi = b_im[(size_t)idx * 16 + ch];
                    const float vr = fr_ * br - fi_ * bi, vi = fr_ * bi + fi_ * br;
                    const int lane = (pp & 31) + 32 * (ch >> 3), j = ch & 7, pt = pp >> 5;
                    sb[((size_t)((dir * 24 + g) * 4 + 0 + pt) * 64 + lane) * 8 + j] = f2bf(vr);
                    sb[((size_t)((dir * 24 + g) * 4 + 2 + pt) * 64 + lane) * 8 + j] = f2bf(vi);
                }
                {
                    const int pt = pp >> 5, p5 = pp & 31, s = p5 >> 4, rem = p5 & 15, hh = (rem >> 2) & 1, j = ((rem >> 3) << 2) | (rem & 3);
                    for (int r = 0; r < 32; ++r) {
                        const float c_r = c_re[((size_t)g * 16 + (r & 15)) * 64 + pp], c_i = c_im[((size_t)g * 16 + (r & 15)) * 64 + pp];
                        const float cr = r < 16 ? c_r : c_r * ar - c_i * ai, ci = r < 16 ? -c_i : -(c_r * ai + c_i * ar);
                        const int lane = r + 32 * hh;
                        sc[((size_t)(((dir * 24 + g) * 4 + 0 + pt) * 2 + s) * 64 + lane) * 8 + j] = f2bf(cr);
                        sc[((size_t)(((dir * 24 + g) * 4 + 2 + pt) * 2 + s) * 64 + lane) * 8 + j] = f2bf(ci);
                    }
                }
            }
            bf16_t* cbt = (bf16_t*)(wl + O_CB);
            {
                const int lane_ = tid & 63;
                for (int w = bid * 8 + (tid >> 6); w < 2 * 24 * 256; w += nblk * 8) {
                    const int c = w & 15, ch = (w >> 4) & 15, g = (w >> 8) % 24, dir = w / (256 * 24);
                    const int li = (dir * 24 + g) * 64 + lane_;
                    const float dt = expf(log_dt[dir * 24 + g]), lr = lam_re[li], li_ = lam_im[li];
                    const float mag = expf(lr * dt); float sn, cs; sincosf(li_ * dt, &sn, &cs);
                    const float xr = mag * cs - 1.0f, xi = mag * sn, den = 1.0f / (lr * lr + li_ * li_);
                    const float f_r = (xr * lr + xi * li_) * den, f_i = (xi * lr - xr * li_) * den;
                    const float br = b_re[(size_t)li * 16 + c], bi = b_im[(size_t)li * 16 + c];
                    const float vr = f_r * br - f_i * bi, vi = f_r * bi + f_i * br;
                    float acc = c_re[((size_t)g * 16 + ch) * 64 + lane_] * vr - c_im[((size_t)g * 16 + ch) * 64 + lane_] * vi;
                    acc += bperm(acc, lane_ ^ 32); acc += bperm(acc, lane_ ^ 16); acc += bperm(acc, lane_ ^ 8); acc += bperm(acc, lane_ ^ 4); acc += bperm(acc, lane_ ^ 2); acc += bperm(acc, lane_ ^ 1);
                    if (lane_ == 0) { const size_t base = ((size_t)(dir * 24 + g) * 64 + 32 * (c >> 3)) * 8 + (c & 7);
                        cbt[base + (size_t)(16 + ch) * 8] = f2bf(acc); cbt[base + (size_t)ch * 8] = 0; }
                }
            }
        }
    }
    {
        bf16_t* dft = (bf16_t*)(p.ws + O_DFT);
        const float sc_ = 0.02209708691f;
        for (int idx = bid * NTHREADS + tid; idx < 2048 * 256; idx += nblk * NTHREADS) {
            const int row = idx >> 8, k8 = (idx & 255) * 8, j = (row & 1023) + 1;
            float v[8];
#pragma unroll
            for (int q = 0; q < 8; ++q) { const int m = (j * (k8 + q)) & 2047; float sn, cs; sincospif((float)m * (1.0f / 1024.0f), &sn, &cs); v[q] = (row < 1024 ? cs : sn) * sc_; }
            u32x4 w; w.x = pk_bf16(v[0], v[1]); w.y = pk_bf16(v[2], v[3]); w.z = pk_bf16(v[4], v[5]); w.w = pk_bf16(v[6], v[7]);
            *(u32x4*)(dft + (size_t)row * 2048 + k8) = w;
        }
    }
    {
        float* mod = (float*)(p.ws + O_MOD);
        LAS float* cl = (LAS float*)lds;
        LAS float* red = cl + 16 * 1024;
        for (int j = (bid + nblk - 32) % nblk; j < 192; j += nblk) {
            const int l = j / 96, c0 = (j % 96) * 64;
            __syncthreads();
            for (int i = tid; i < 16 * 1024; i += NTHREADS) cl[i] = p.in[I_C][i];
            __syncthreads();
            const int kg = tid >> 6, col = tid & 63;
            const float* w = p.in[I_WADA] + (size_t)l * 1024 * 6144 + c0 + col;
            float a[16];
#pragma unroll
            for (int b = 0; b < 16; ++b) a[b] = 0.f;
            for (int k0 = kg * 128; k0 < kg * 128 + 128; k0 += 16) {
                float wv[16];
#pragma unroll
                for (int q = 0; q < 16; ++q) wv[q] = w[(size_t)(k0 + q) * 6144];
#pragma unroll
                for (int q = 0; q < 16; ++q)
#pragma unroll
                    for (int b = 0; b < 16; ++b) a[b] += cl[b * 1024 + k0 + q] * wv[q];
            }
#pragma unroll
            for (int b = 0; b < 16; ++b) red[(kg * 16 + b) * 64 + col] = a[b];
            __syncthreads();
            for (int o = tid; o < 16 * 64; o += NTHREADS) { const int b = o >> 6, cc = o & 63; float s = p.in[I_BADA][l * 6144 + c0 + cc];
#pragma unroll
                for (int q = 0; q < 8; ++q) s += red[(q * 16 + b) * 64 + cc];
                mod[((size_t)l * 16 + b) * 6144 + c0 + cc] = s; }
        }
    }
}

DI float wave_sum(float v, int lane) {
    v += bperm(v, lane ^ 32); v += bperm(v, lane ^ 16); v += bperm(v, lane ^ 8); v += bperm(v, lane ^ 4); v += bperm(v, lane ^ 2); v += bperm(v, lane ^ 1); return v; }
template <bool XB>
DI void phase_rows(const float* xin, const bf16_t* xin_b, float* xout, bf16_t* xout_b, const bf16_t* y, const float* rss, const float* modr, int gate_off, const float* g_post, bool do_res,
                   bool do_h, const float* modh, int sh_off, int sc_off, const float* g_pre, bf16_t* hout) {
    const int tid_ = otid(), lane = tid_ & 63, wid = tid_ >> 6;
#define RCOL(i) (lane * 8 + 512 * ((i) >> 1) + 4 * ((i) & 1))
    f32x4 gp[4], gq[4];
#pragma unroll
    for (int i = 0; i < 4; ++i) { const int c = RCOL(i); gp[i] = do_res ? *(const f32x4*)(g_post + c) : (f32x4){0.f, 0.f, 0.f, 0.f}; gq[i] = do_h ? *(const f32x4*)(g_pre + c) : (f32x4){0.f, 0.f, 0.f, 0.f}; }
    const int rstride = (int)gridDim.x * 32;
    u32x4 xr[4][2], yr[4][2]; float rsr[4];
#define ROWS_LOAD_RAW(R0) do { _Pragma("unroll") for (int r = 0; r < 4; ++r) { _Pragma("unroll") for (int h = 0; h < 2; ++h) { \
        xr[r][h] = *(const u32x4*)(xin_b + (size_t)((R0) + r) * 1024 + lane * 8 + 512 * h); yr[r][h] = *(const u32x4*)(y + (size_t)((R0) + r) * 1024 + lane * 8 + 512 * h); } \
        rsr[r] = rss[(size_t)((R0) + r) * 16 + (lane & 15)]; } } while (0)
    const int row_first = (obid() * 8 + wid) * 4;
    if (XB) { if (row_first < MTOK) ROWS_LOAD_RAW(row_first); }
    for (int row0 = row_first; row0 < MTOK; row0 += rstride) {
        const int b = row0 >> 11;
        f32x4 x[4][4]; u32x4 yw[4][2]; float rs[4];
        if (XB) {
#pragma unroll
            for (int r = 0; r < 4; ++r) {
#pragma unroll
                for (int h = 0; h < 2; ++h) { const u32x4 w = xr[r][h]; yw[r][h] = yr[r][h];
                    x[r][2 * h] = (f32x4){bf_lo(w.x), bf_hi(w.x), bf_lo(w.y), bf_hi(w.y)}; x[r][2 * h + 1] = (f32x4){bf_lo(w.z), bf_hi(w.z), bf_lo(w.w), bf_hi(w.w)}; }
                rs[r] = rsr[r]; }
            if (row0 + rstride < MTOK) ROWS_LOAD_RAW(row0 + rstride);
        } else {
#pragma unroll
            for (int r = 0; r < 4; ++r)
#pragma unroll
                for (int i = 0; i < 4; ++i) x[r][i] = *(const f32x4*)(xin + (size_t)(row0 + r) * 1024 + RCOL(i));
        }
        if (do_res) {
            if (!XB) {
#pragma unroll
                for (int r = 0; r < 4; ++r) {
#pragma unroll
                    for (int h = 0; h < 2; ++h) yw[r][h] = *(const u32x4*)(y + (size_t)(row0 + r) * 1024 + lane * 8 + 512 * h);
                    rs[r] = rss[(size_t)(row0 + r) * 16 + (lane & 15)];
                }
            }
            float rstdy[4];
#pragma unroll
            for (int r = 0; r < 4; ++r) { float ss = rs[r]; ss += bperm(ss, lane ^ 1); ss += bperm(ss, lane ^ 2); ss += bperm(ss, lane ^ 4); ss += bperm(ss, lane ^ 8); rstdy[r] = rsqrtf(ss * (1.0f / 1024.0f) + 1e-6f); }
#pragma unroll
            for (int h = 0; h < 2; ++h) {
                const f32x4 gt0 = *(const f32x4*)(modr + (size_t)b * 6144 + gate_off + RCOL(2 * h)) * gp[2 * h], gt1 = *(const f32x4*)(modr + (size_t)b * 6144 + gate_off + RCOL(2 * h + 1)) * gp[2 * h + 1];
#pragma unroll
                for (int r = 0; r < 4; ++r) {
                    const u32x4 w = yw[r][h]; const float rstd = rstdy[r];
                    f32x4& a = x[r][2 * h]; f32x4& c2 = x[r][2 * h + 1];
                    a[0] += gt0[0] * (bf_lo(w.x) * rstd); a[1] += gt0[1] * (bf_hi(w.x) * rstd); a[2] += gt0[2] * (bf_lo(w.y) * rstd); a[3] += gt0[3] * (bf_hi(w.y) * rstd);
                    c2[0] += gt1[0] * (bf_lo(w.z) * rstd); c2[1] += gt1[1] * (bf_hi(w.z) * rstd); c2[2] += gt1[2] * (bf_lo(w.w) * rstd); c2[3] += gt1[3] * (bf_hi(w.w) * rstd);
                    if (xout_b) { u32x4 o; o.x = pk_bf16(a[0], a[1]); o.y = pk_bf16(a[2], a[3]); o.z = pk_bf16(c2[0], c2[1]); o.w = pk_bf16(c2[2], c2[3]);
                        *(u32x4*)(xout_b + (size_t)(row0 + r) * 1024 + lane * 8 + 512 * h) = o;
                        a = (f32x4){bf_lo(o.x), bf_hi(o.x), bf_lo(o.y), bf_hi(o.y)}; c2 = (f32x4){bf_lo(o.z), bf_hi(o.z), bf_lo(o.w), bf_hi(o.w)}; }
                    else { *(f32x4*)(xout + (size_t)(row0 + r) * 1024 + RCOL(2 * h)) = a; *(f32x4*)(xout + (size_t)(row0 + r) * 1024 + RCOL(2 * h + 1)) = c2; }
                }
            }
        }
        if (do_h) {
            float rstd[4];
#pragma unroll
            for (int r = 0; r < 4; ++r) { float ss = 0.f;
#pragma unroll
                for (int i = 0; i < 4; ++i) ss += (x[r][i][0] * x[r][i][0] + x[r][i][1] * x[r][i][1]) + (x[r][i][2] * x[r][i][2] + x[r][i][3] * x[r][i][3]);
                rstd[r] = rsqrtf(wave_sum(ss, lane) * (1.0f / 1024.0f) + 1e-6f); }
#pragma unroll
            for (int h = 0; h < 2; ++h) {
                f32x4 gg[2], sh[2];
#pragma unroll
                for (int q = 0; q < 2; ++q) { const int c = RCOL(2 * h + q);
                    const f32x4 sc = *(const f32x4*)(modh + (size_t)b * 6144 + sc_off + c); sh[q] = *(const f32x4*)(modh + (size_t)b * 6144 + sh_off + c); gg[q] = gq[2 * h + q] * (sc + 1.0f); }
#pragma unroll
                for (int r = 0; r < 4; ++r) {
                    const f32x4 a = x[r][2 * h] * rstd[r] * gg[0] + sh[0], c2 = x[r][2 * h + 1] * rstd[r] * gg[1] + sh[1];
                    u32x4 o; o.x = pk_bf16(a[0], a[1]); o.y = pk_bf16(a[2], a[3]); o.z = pk_bf16(c2[0], c2[1]); o.w = pk_bf16(c2[2], c2[3]);
                    *(u32x4*)(hout + (size_t)(row0 + r) * 1024 + lane * 8 + 512 * h) = o; }
            }
        }
    }
#undef RCOL
#undef ROWS_LOAD_RAW
}

DI bf16x8 ld_u(const bf16_t* p) { return *(const bf16x8*)p; }
DI void ssm_item(const Params& p, LAS unsigned char* lds, int l, int item) {
    const int tid = otid(), wid = tid >> 6, lane = tid & 63, n = lane & 31, hh = lane >> 5;
    const int g = item >> 2, b = (item & 3) * 4 + (wid >> 1), dir = wid & 1;
    unsigned char* wl = p.ws + l * LAYER_W;
    const u32x4 ctab0 = *(const u32x4*)(wl + O_SC + (size_t)g * 8192 + tid * 16), ctab1 = *(const u32x4*)(wl + O_SC + (size_t)(24 + g) * 8192 + tid * 16);
    const f32x4 atab = *(const f32x4*)((const float*)(wl + O_SA) + (size_t)g * 128 + ((tid & 63) >> 5) * 24 * 128 + (tid & 31) * 4);
    __syncthreads();
    *(LAS u32x4*)(lds + tid * 16) = ctab0; *(LAS u32x4*)(lds + 8192 + tid * 16) = ctab1;
    if (tid < 64) *(LAS f32x4*)(lds + 16384 + tid * 16) = atab;
    __syncthreads();
    const LAS float* la = (const LAS float*)(lds + 16384) + dir * 128 + 4 * hh;
#define SSM_LDA(pt) f32x16 are_, aim_; _Pragma("unroll") for (int q_ = 0; q_ < 4; ++q_) { const f32x4 r4 = *(const LAS f32x4*)(la + (pt) * 32 + 8 * q_), i4 = *(const LAS f32x4*)(la + 64 + (pt) * 32 + 8 * q_); \
        _Pragma("unroll") for (int j_ = 0; j_ < 4; ++j_) { are_[4 * q_ + j_] = r4[j_]; aim_[4 * q_ + j_] = i4[j_]; } }
    bf16x8 bop[4];
#pragma unroll
    for (int t = 0; t < 4; ++t) bop[t] = *(const bf16x8*)((const bf16_t*)(wl + O_SB) + ((size_t)((dir * 24 + g) * 4 + t) * 64 + lane) * 8);
    const bf16_t* ut = (const bf16_t*)(p.ws + O_UT) + (size_t)(b * 24 + g) * (64 * 32 * 16);
    const long tstride = dir ? -512 : 512;
    const bf16_t* ubase = ut + (dir ? (63 * 32 + (31 - n)) * 16 : n * 16) + 8 * hh;
    f32x16 hre[2], him[2];
#pragma unroll
    for (int pt = 0; pt < 2; ++pt)
#pragma unroll
        for (int i = 0; i < 16; ++i) { hre[pt][i] = 0.f; him[pt][i] = 0.f; }
    {
        const int widu = __builtin_amdgcn_readfirstlane(wid);
        LAS unsigned char* ust = lds + 20480 + widu * 16384;
#pragma unroll
        for (int q = 0; q < 8; ++q) __builtin_amdgcn_global_load_lds((const unsigned*)(ubase + q * tstride), (LAS unsigned*)(ust + q * 1024), 16, 0, 0);
        for (int i0 = 0; i0 < 64; i0 += 8) {
            const int cur = (i0 >> 3) & 1;
            asm volatile("s_waitcnt vmcnt(0)" ::: "memory");
            if (i0 + 8 < 64) {
#pragma unroll
                for (int q = 0; q < 8; ++q) __builtin_amdgcn_global_load_lds((const unsigned*)(ubase + (i0 + 8 + q) * tstride), (LAS unsigned*)(ust + (cur ^ 1) * 8192 + q * 1024), 16, 0, 0);
            }
#pragma unroll
            for (int q = 0; q < 8; ++q) {
                const bf16x8 uc = *(const LAS bf16x8*)(ust + cur * 8192 + q * 1024 + lane * 16);
#pragma unroll
                for (int pt = 0; pt < 2; ++pt) {
                    asm volatile("" ::: "memory");
                    SSM_LDA(pt)
                    const f32x16 tr = are_ * hre[pt] - aim_ * him[pt], ti = are_ * him[pt] + aim_ * hre[pt];
                    hre[pt] = MFMA32(bop[pt], uc, tr); him[pt] = MFMA32(bop[2 + pt], uc, ti);
                }
            }
        }
    }
#pragma unroll
    for (int pt = 0; pt < 2; ++pt) {
        SSM_LDA(pt)
        f32x16 pr = are_, pi = aim_;
#pragma unroll
        for (int s = 0; s < 6; ++s) { const f32x16 nr = pr * pr - pi * pi, ni = 2.0f * pr * pi; pr = nr; pi = ni; }
#pragma unroll
        for (int d = 1; d < 32; d <<= 1) {
            const bool take = n >= d; const int src = take ? lane - d : lane;
#pragma unroll
            for (int i = 0; i < 16; ++i) {
                const float sr = bperm(hre[pt][i], src), si = bperm(him[pt][i], src);
                if (take) { hre[pt][i] += pr[i] * sr - pi[i] * si; him[pt][i] += pr[i] * si + pi[i] * sr; }
            }
            const f32x16 nr = pr * pr - pi * pi, ni = 2.0f * pr * pi; pr = nr; pi = ni;
        }
#pragma unroll
        for (int i = 0; i < 16; ++i) { const int src1 = n ? lane - 1 : lane; const float sr = bperm(hre[pt][i], src1), si = bperm(him[pt][i], src1); hre[pt][i] = n ? sr : 0.f; him[pt][i] = n ? si : 0.f; }
        asm volatile("" ::: "memory");
    }
    {
        float* yt = (float*)(p.ws + O_YFB) + (size_t)dir * MTOK * 384 + (size_t)(b * 24 + g) * (64 * 32 * 16);
        float* ybase = yt + (dir ? (63 * 32 + (31 - n)) * 16 : n * 16) + 4 * hh;
        const int widu = __builtin_amdgcn_readfirstlane(wid);
        const bf16x8 cbop = *(const bf16x8*)((const bf16_t*)(wl + O_CB) + ((size_t)(dir * 24 + g) * 64 + lane) * 8);
        f32x16 yacc;
#pragma unroll
        for (int i = 0; i < 16; ++i) yacc[i] = 0.f;
        LAS unsigned char* ust = lds + 20480 + widu * 16384;
#pragma unroll
        for (int q = 0; q < 8; ++q) __builtin_amdgcn_global_load_lds((const unsigned*)(ubase + q * tstride), (LAS unsigned*)(ust + q * 1024), 16, 0, 0);
        for (int i0 = 0; i0 < 64; i0 += 8) {
            const int cur = (i0 >> 3) & 1;
            asm volatile("s_waitcnt vmcnt(0)" ::: "memory");
            if (i0 + 8 < 64) {
#pragma unroll
                for (int q = 0; q < 8; ++q) __builtin_amdgcn_global_load_lds((const unsigned*)(ubase + (i0 + 8 + q) * tstride), (LAS unsigned*)(ust + (cur ^ 1) * 8192 + q * 1024), 16, 0, 0);
            }
#pragma unroll
            for (int q = 0; q < 8; ++q) {
                const bf16x8 uc = *(const LAS bf16x8*)(ust + cur * 8192 + q * 1024 + lane * 16);
#pragma unroll
                for (int pt = 0; pt < 2; ++pt) {
                    asm volatile("" ::: "memory");
                    SSM_LDA(pt)
                    const f32x16 tr = are_ * hre[pt] - aim_ * him[pt], ti = are_ * him[pt] + aim_ * hre[pt];
                    hre[pt] = MFMA32(bop[pt], uc, tr); him[pt] = MFMA32(bop[2 + pt], uc, ti);
                }
                if ((q & 1) == 0) {
                    f32x16 yac2;
#pragma unroll
                    for (int i = 0; i < 16; ++i) { yacc[i] = 0.f; yac2[i] = 0.f; }
#pragma unroll
                    for (int T = 0; T < 2; ++T) {
#pragma unroll
                        for (int s = 0; s < 2; ++s) {
                            const f32x16 hv = hre[T], hw = him[T];
                            const bf16x8 hb = pack8(hv[8 * s], hv[8 * s + 1], hv[8 * s + 2], hv[8 * s + 3], hv[8 * s + 4], hv[8 * s + 5], hv[8 * s + 6], hv[8 * s + 7]);
                            const bf16x8 hc = pack8(hw[8 * s], hw[8 * s + 1], hw[8 * s + 2], hw[8 * s + 3], hw[8 * s + 4], hw[8 * s + 5], hw[8 * s + 6], hw[8 * s + 7]);
                            const bf16x8 cop = *(const LAS bf16x8*)(lds + dir * 8192 + ((T * 2 + s) * 64 + lane) * 16);
                            const bf16x8 coq = *(const LAS bf16x8*)(lds + dir * 8192 + (((2 + T) * 2 + s) * 64 + lane) * 16);
                            yacc = MFMA32(cop, hb, yacc);
                            yac2 = MFMA32(coq, hc, yac2);
                        }
                    }
                    yacc += yac2;
                    float* yp = ybase + (i0 + q) * tstride;
                    *(f32x4*)yp = (f32x4){yacc[0], yacc[1], yacc[2], yacc[3]};
                    *(f32x4*)(yp + 8) = (f32x4){yacc[4], yacc[5], yacc[6], yacc[7]};
                } else {
                    yacc = MFMA32(cbop, uc, yacc);
                    float* yp = ybase + (i0 + q) * tstride;
                    *(f32x4*)yp = (f32x4){yacc[8], yacc[9], yacc[10], yacc[11]};
                    *(f32x4*)(yp + 8) = (f32x4){yacc[12], yacc[13], yacc[14], yacc[15]};
                }
            }
        }
    }
    __syncthreads();
    {
        const float* yf = (const float*)(p.ws + O_YFB) + (size_t)(b * 24 + g) * (64 * 32 * 16); const float* yb = yf + (size_t)MTOK * 384;
        bf16_t* ypre = (bf16_t*)(p.ws + O_YPRE);
        const float* dsk = p.in[I_DSKIP] + l * 384 + g * 16;
        const int t2 = tid & 127;
        const f32x4 d4 = *(const f32x4*)(dsk + (t2 & 3) * 4);
        for (int it = 0; it < 64; it += 8) {
            f32x4 a[8], bb[8]; u32x2 uw[8];
#pragma unroll
            for (int q = 0; q < 8; ++q) { const int idx = t2 + 128 * (it + q), c4 = (idx & 3) * 4, nn = (idx >> 2) & 31, ii = idx >> 7, e = (ii * 32 + nn) * 16 + c4;
                a[q] = *(const f32x4*)(yf + e); bb[q] = *(const f32x4*)(yb + e); uw[q] = *(const u32x2*)(ut + e); }
#pragma unroll
            for (int q = 0; q < 8; ++q) { const int idx = t2 + 128 * (it + q), c4 = (idx & 3) * 4, nn = (idx >> 2) & 31, ii = idx >> 7;
                const size_t tok = (size_t)b * 2048 + 64 * nn + ii;
                const float y0 = a[q][0] + bb[q][0] + d4[0] * bf_lo(uw[q].x), y1 = a[q][1] + bb[q][1] + d4[1] * bf_hi(uw[q].x), y2 = a[q][2] + bb[q][2] + d4[2] * bf_lo(uw[q].y), y3 = a[q][3] + bb[q][3] + d4[3] * bf_hi(uw[q].y);
                u32x2 w; w.x = pk_bf16(gelu_tanh(y0), gelu_tanh(y1)); w.y = pk_bf16(gelu_tanh(y2), gelu_tanh(y3));
                *(u32x2*)(ypre + tok * 384 + g * 16 + c4) = w; }
        }
    }
}

DI void attn_item(const Params& p, LAS unsigned char* lds, int l, int item) {
    const int tid = otid(), wid = tid >> 6, lane = tid & 63, n = lane & 31, hh = lane >> 5;
    const int b = item >> 5, blk = (item >> 1) & 15, kvh = item & 1;
    const bf16_t* z = (const bf16_t*)(p.ws + O_Z);
    bf16_t* ycat = (bf16_t*)(p.ws + O_YCAT);
    constexpr int KROW = 144, VROW = 784, VOFF = 384 * KROW;
    __syncthreads();
    for (int c = tid; c < 3072; c += NTHREADS) {
        const int j = c >> 3, dc = c & 7, pos = blk * 128 - 128 + j;
        u32x4 kv = {0u, 0u, 0u, 0u};
        if (pos >= 0 && pos < 2048) kv = *(const u32x4*)(z + ((size_t)b * 2048 + pos) * 1024 + 768 + kvh * 64 + dc * 8);
        *(LAS u32x4*)(lds + j * KROW + dc * 16) = kv;
    }
    for (int c = tid; c < 3072; c += NTHREADS) {
        const int j = c % 384, dc = c / 384, pos = blk * 128 - 128 + j;
        u32x4 vv = {0u, 0u, 0u, 0u};
        if (pos >= 0 && pos < 2048) vv = *(const u32x4*)(z + ((size_t)b * 2048 + pos) * 1024 + 896 + kvh * 64 + dc * 8);
        LAS bf16_t* vt = (LAS bf16_t*)(lds + VOFF + (dc * 8) * VROW) + j;
        vt[0 * (VROW / 2)] = (bf16_t)(vv.x & 0xffff); vt[1 * (VROW / 2)] = (bf16_t)(vv.x >> 16);
        vt[2 * (VROW / 2)] = (bf16_t)(vv.y & 0xffff); vt[3 * (VROW / 2)] = (bf16_t)(vv.y >> 16);
        vt[4 * (VROW / 2)] = (bf16_t)(vv.z & 0xffff); vt[5 * (VROW / 2)] = (bf16_t)(vv.z >> 16);
        vt[6 * (VROW / 2)] = (bf16_t)(vv.w & 0xffff); vt[7 * (VROW / 2)] = (bf16_t)(vv.w >> 16);
    }
    __syncthreads();
    for (int task = wid; task < 12; task += 8) {
        const int head = kvh * 3 + (task >> 2), qt = task & 3;
        const float slope2 = exp2f(-8.0f * (float)(head + 1) / 6.0f) * 1.442695041f;
        const float sink2 = p.in[I_SINK][l * 6 + head] * 1.442695041f;
        const int qi = 32 * qt + n;
        const size_t tok = (size_t)b * 2048 + blk * 128 + qi;
        bf16x8 qop[4];
#pragma unroll
        for (int s = 0; s < 4; ++s) qop[s] = *(const bf16x8*)(z + tok * 1024 + 384 + head * 64 + 16 * s + 8 * hh);
        f32x16 o0, o1;
#pragma unroll
        for (int i = 0; i < 16; ++i) { o0[i] = 0.f; o1[i] = 0.f; }
        float mrun = sink2, lrun = 0.f;
        float dbase[16];
#pragma unroll
        for (int r = 0; r < 16; ++r) dbase[r] = (float)(128 + n - ((r & 3) + 8 * (r >> 2) + 4 * hh));
        const bool edge_blk = (blk == 0) || (blk == 15);
        for (int kt = qt; kt < qt + 9; ++kt) {
            f32x16 sacc;
#pragma unroll
            for (int i = 0; i < 16; ++i) sacc[i] = 0.f;
#pragma unroll
            for (int s = 0; s < 4; ++s) { const bf16x8 kop = *(const LAS bf16x8*)(lds + (kt * 32 + n) * KROW + (16 * s + 8 * hh) * 2); sacc = MFMA32(kop, qop[s], sacc); }
            const int dk = kt - qt;
            const float off = 32.0f * (float)dk;
            float mx = -1e30f;
            if (dk == 0 || dk == 8 || edge_blk) {
#pragma unroll
                for (int r = 0; r < 16; ++r) {
                    const int j = kt * 32 + (r & 3) + 8 * (r >> 2) + 4 * hh, pos = blk * 128 - 128 + j;
                    const float d = dbase[r] - off;
                    const bool valid = fabsf(d) <= 128.0f && pos >= 0 && pos < 2048;
                    const float sc = valid ? sacc[r] * 0.1803368801f - slope2 * fabsf(d) : -1e30f;
                    sacc[r] = sc; mx = fmaxf(mx, sc);
                }
            } else {
#pragma unroll
                for (int r = 0; r < 16; ++r) { const float sc = sacc[r] * 0.1803368801f - slope2 * fabsf(dbase[r] - off); sacc[r] = sc; mx = fmaxf(mx, sc); }
            }
            mx = fmaxf(mx, bperm(mx, lane ^ 32));
            const float mnew = fmaxf(mrun, mx);
            if (__builtin_amdgcn_ballot_w64(mnew != mrun) != 0ull) {
                const float alpha = __builtin_amdgcn_exp2f(mrun - mnew);
                lrun *= alpha; o0 *= alpha; o1 *= alpha; mrun = mnew;
            }
            float ls = 0.f;
#pragma unroll
            for (int r = 0; r < 16; ++r) { const float pv = __builtin_amdgcn_exp2f(sacc[r] - mrun); sacc[r] = pv; ls += pv; }
            lrun += ls;
#pragma unroll
            for (int s = 0; s < 2; ++s) {
                const bf16x8 pb = pack8(sacc[8 * s], sacc[8 * s + 1], sacc[8 * s + 2], sacc[8 * s + 3], sacc[8 * s + 4], sacc[8 * s + 5], sacc[8 * s + 6], sacc[8 * s + 7]);
#pragma unroll
                for (int dt = 0; dt < 2; ++dt) {
                    const LAS unsigned char* vp = lds + VOFF + (dt * 32 + n) * VROW + (kt * 32 + 16 * s + 4 * hh) * 2;
                    const s16x4 lo = *(const LAS s16x4*)vp, hi = *(const LAS s16x4*)(vp + 16);
                    const bf16x8 vop = __builtin_shufflevector(lo, hi, 0, 1, 2, 3, 4, 5, 6, 7);
                    if (dt == 0) o0 = MFMA32(vop, pb, o0); else o1 = MFMA32(vop, pb, o1);
                }
            }
        }
        const float ltot = lrun + bperm(lrun, lane ^ 32);
        const float inv = 1.0f / (ltot + __builtin_amdgcn_exp2f(sink2 - mrun));
        bf16_t* op = ycat + tok * 1024 + 640 + head * 64 + 4 * hh;
#pragma unroll
        for (int q = 0; q < 4; ++q) {
            u32x2 w0; w0.x = pk_bf16(o0[4 * q] * inv, o0[4 * q + 1] * inv); w0.y = pk_bf16(o0[4 * q + 2] * inv, o0[4 * q + 3] * inv);
            u32x2 w1; w1.x = pk_bf16(o1[4 * q] * inv, o1[4 * q + 1] * inv); w1.y = pk_bf16(o1[4 * q + 2] * inv, o1[4 * q + 3] * inv);
            *(u32x2*)(op + 8 * q) = w0; *(u32x2*)(op + 32 + 8 * q) = w1;
        }
    }
}

#define XB_TMO      128
#define XB_XCNT(j)  (256  + 64 * (j))
#define XB_XSUB(j)  (1280 + 64 * (j))
#define XB_XGEN(j)  (2304 + 64 * (j))
#define XB_TOP      3328
#define XB_TOPGEN   3392
#define XB_SPIN_CAP (1u << 20)
DI unsigned xb_ld(unsigned* p) { return __hip_atomic_load(p, __ATOMIC_RELAXED, __HIP_MEMORY_SCOPE_AGENT); }
DI unsigned xb_add(unsigned* p, unsigned v) { return __hip_atomic_fetch_add(p, v, __ATOMIC_RELAXED, __HIP_MEMORY_SCOPE_AGENT); }
DI unsigned xb_xcc_id() { return (unsigned)__builtin_amdgcn_s_getreg((3 << 11) | 20) & 0xFu; }
#define XB_SPIN(cond, bar) do { unsigned _sp = 0; while (cond) { __builtin_amdgcn_s_sleep(1); \
    if ((++_sp & 255u) == 0u) { if (xb_ld(&(bar)[XB_TMO])) break; if (_sp > XB_SPIN_CAP) { atomicAdd(&(bar)[XB_TMO], 1u); break; } } } } while (0)
DI void xcd_barrier_complete(unsigned* bar, unsigned x, unsigned& nloc, unsigned& nx) {
    const unsigned G = gridDim.x;
    unsigned sum, cnt, mine, sp = 0u;
    for (;;) {
        sum = 0u; cnt = 0u; mine = 0u;
#pragma unroll
        for (unsigned j = 0; j < 16; ++j) { const unsigned c = xb_ld(&bar[XB_XCNT(j)]); sum += c; cnt += (c > 0u) ? 1u : 0u; mine = (j == x) ? c : mine; }
        if (sum == G) break;
        __builtin_amdgcn_s_sleep(1);
        if ((++sp & 255u) == 0u) { if (xb_ld(&bar[XB_TMO])) break; if (sp > XB_SPIN_CAP) { atomicAdd(&bar[XB_TMO], 1u); break; } }
    }
    nloc = mine > 0u ? mine : 1u; nx = cnt > 0u ? cnt : 1u;
}
DI void xcd_barrier(unsigned* bar, volatile LAS unsigned* st) {
    asm volatile("s_waitcnt vmcnt(0)" ::: "memory");
    __syncthreads();
    if (otid() == 0) {
        __builtin_amdgcn_s_waitcnt(0);
        const unsigned x = xb_xcc_id();
        unsigned nloc = st[0], nx = st[1];
        if (nloc == 0u) { xcd_barrier_complete(bar, x, nloc, nx); st[0] = nloc; st[1] = nx; }
        const unsigned old = xb_add(&bar[XB_XSUB(x)], 1u);
        const unsigned gen = old / nloc;
        if (old + 1u == (gen + 1u) * nloc) {
            __builtin_amdgcn_fence(__ATOMIC_RELEASE, "agent");
            asm volatile("s_waitcnt vmcnt(0)" ::: "memory");
            const unsigned og = xb_add(&bar[XB_TOP], 1u);
            const unsigned tg = og / nx;
            if (og + 1u == (tg + 1u) * nx) xb_add(&bar[XB_TOPGEN], 1u);
            else XB_SPIN(xb_ld(&bar[XB_TOPGEN]) == tg, bar);
            __builtin_amdgcn_fence(__ATOMIC_ACQUIRE, "agent");
            xb_add(&bar[XB_XGEN(x)], 1u);
            asm volatile("s_waitcnt vmcnt(0)" ::: "memory");
        } else {
            XB_SPIN(xb_ld(&bar[XB_XGEN(x)]) == gen, bar);
            __builtin_amdgcn_fence(__ATOMIC_ACQUIRE, "agent");
            asm volatile("s_waitcnt vmcnt(0)" ::: "memory");
        }
    }
    __syncthreads();
}
#define EN(k) (((PHASE_EN) >> (k)) & 1u)
constexpr int NPHASE = 2 + 9 * NL;
template <unsigned PHASE_EN> __global__ void __launch_bounds__(NTHREADS, 2) fwd_megakernel(Params p_arg) {
    extern __shared__ __attribute__((aligned(16))) unsigned char lds_raw[];
    LAS unsigned char* lds = (LAS unsigned char*)lds_raw;
    cg::grid_group grid = cg::this_grid();
    const int ph_lo = p_arg.ph_lo, ph_hi = p_arg.ph_hi;
    volatile LAS unsigned* xst = (volatile LAS unsigned*)(lds + LDS_BYTES - 32);
    if (threadIdx.x == 0) { xst[0] = 0u; xst[1] = 0u; (void)xb_add((unsigned*)(p_arg.ws + O_CTR + 1024) + XB_XCNT(xb_xcc_id()), 1u); }
    __syncthreads();
    for (int ph = ph_lo; ph < ph_hi; ++ph) {
#if defined(__HIP_DEVICE_COMPILE__)
        const __attribute__((address_space(4))) Params* pp = (const __attribute__((address_space(4))) Params*)__builtin_amdgcn_kernarg_segment_ptr();
        asm volatile("" : "+s"(pp));
        const Params p = *pp;
#else
        const Params p = p_arg;
#endif
        unsigned char* ws = p.ws;
        const float* mod = (const float*)(ws + O_MOD);
        if (ph == 0) { if (EN(0)) phase_prep(p, lds); }
        else if (ph == 1) {
            if (EN(1)) phase_rows<false>(p.in[I_X], nullptr, nullptr, nullptr, nullptr, nullptr, nullptr, 0, nullptr, false, true, mod, 0, 1024, p.in[I_GPREMIX], (bf16_t*)(ws + O_H));
        } else {
            const int l = (ph - 2) / 9, sp = (ph - 2) % 9;
            unsigned char* wl = ws + l * LAYER_W;
            const float* modl = mod + (size_t)l * 16 * 6144;
            if (sp == 0) {
                SchedInproj S; S.bid = obid(); S.h = (const char*)(ws + O_H); S.win = (const char*)(wl + O_WIN); S.wpq = (const char*)(wl + O_WPQ); S.z = (char*)(ws + O_Z); S.pqt = (char*)(ws + O_PQT);
                S.m1.init(128, 4); S.m2.init(2, 128);
                EpiInproj E; E.ut = (bf16_t*)(ws + O_UT); if (EN(2)) gemm_phase(lds, 1024, 1024, 1024, 1 << 30, 0, S, E);
            } else if (sp == 1) {
                unsigned* ctr = (unsigned*)(ws + O_CTR) + l;
                LAS int* sitem = (LAS int*)(lds + LDS_BYTES - 16);
                for (;;) {
                    __syncthreads();
                    if (otid() == 0) *sitem = (int)atomicAdd(ctr, 1u);
                    __syncthreads();
                    const int item = *sitem;
                    if (item >= 128 + 96 + 512) break;
                    if (item < 128) {
                        const int bb = item >> 3, which = (item >> 2) & 1, jt = item & 3;
                        SchedOne S; S.u0.A = (const char*)(ws + O_DFT) + (size_t)(which * 1024 + jt * 256) * 2048 * 2; S.u0.B = (const char*)(ws + O_PQT) + ((size_t)which * 256 * MTOK + (size_t)bb * 2048) * 2;
                        S.u0.C = (char*)(ws + O_AB) + ((size_t)((which * 16 + bb) * 1024 + jt * 256) * 256) * 4; S.u0.ldc = 256; S.u0.pm = jt; S.u0.pn = bb; S.u0.kind = 1;
                        EpiF32 E; if (EN(3)) gemm_phase(lds, 2048, 2048, MTOK, 1 << 30, 0, S, E);
                    } else if (item < 224) { if (EN(4)) ssm_item(p, lds, l, item - 128); }
                    else { if (EN(5)) attn_item(p, lds, l, item - 224); }
                }
            } else if (sp == 2) {
                {
                    const float* ab = (const float*)(ws + O_AB); bf16_t* yc = (bf16_t*)(ws + O_YCAT);
                    const int gt_ = obid() * NTHREADS + otid();
                    const int gstride = (int)gridDim.x * NTHREADS;
                    for (int idx0 = gt_; idx0 < 16 * 1024 * 64; idx0 += 8 * gstride) {
                        f32x4 av[8], bv[8];
#pragma unroll
                        for (int q = 0; q < 8; ++q) { const int idx = idx0 + q * gstride; const bool ok = idx < 16 * 1024 * 64;
                            const int n4 = (idx & 63) * 4, jj = (idx >> 6) & 1023, bb = ok ? idx >> 16 : 0;
                            av[q] = *(const f32x4*)(ab + ((size_t)(bb * 1024 + jj) * 256 + n4)); bv[q] = *(const f32x4*)(ab + ((size_t)((16 + bb) * 1024 + jj) * 256 + n4)); }
#pragma unroll
                        for (int q = 0; q < 8; ++q) { const int idx = idx0 + q * gstride;
                            if (idx < 16 * 1024 * 64) {
                                const int n4 = (idx & 63) * 4, jj = (idx >> 6) & 1023, bb = idx >> 16, j = jj + 1;
                                const f32x4 a = av[q], b4 = bv[q];
                                u32x2 lo, hi; lo.x = pk_bf16(a[0] - b4[0], a[1] - b4[1]); lo.y = pk_bf16(a[2] - b4[2], a[3] - b4[3]);
                                hi.x = pk_bf16(a[0] + b4[0], a[1] + b4[1]); hi.y = pk_bf16(a[2] + b4[2], a[3] + b4[3]);
                                *(u32x2*)(yc + ((size_t)(bb * 2048 + j) * 1024 + 384 + n4)) = lo;
                                *(u32x2*)(yc + ((size_t)(bb * 2048 + 2048 - j) * 1024 + 384 + n4)) = hi; } }
                    }
                    const bf16_t* pq = (const bf16_t*)(ws + O_PQT);
                    const int lane_ = otid() & 63;
                    for (int w = gt_ >> 6; w < 16 * 256; w += (int)gridDim.x * 8) {
                        const int bb = w >> 8, n = w & 255;
                        const bf16_t* src = pq + (size_t)n * MTOK + (size_t)bb * 2048 + lane_ * 32;
                        float sum = 0.f;
#pragma unroll
                        for (int q = 0; q < 4; ++q) { const u32x4 v = *(const u32x4*)(src + q * 8);
                            sum += (bf_lo(v.x) + bf_hi(v.x)) + (bf_lo(v.y) + bf_hi(v.y)) + (bf_lo(v.z) + bf_hi(v.z)) + (bf_lo(v.w) + bf_hi(v.w)); }
                        sum = wave_sum(sum, lane_);
                        if (lane_ == 0) yc[(size_t)(bb * 2048) * 1024 + 384 + n] = f2bf(sum * 0.02209708691f);
                    }
                }
                SchedPlain S; S.bid = obid(); S.A = (const char*)(ws + O_YPRE); S.B = (const char*)(wl + O_WGLU); S.K = 384; S.total = 256; S.tm.init(128, 2);
                EpiGlu E; E.ypre = (const bf16_t*)(ws + O_YPRE); E.ycat = (bf16_t*)(ws + O_YCAT);
                if (EN(6)) gemm_phase(lds, 384, 384, 384, 1 << 30, 0, S, E);
            } else if (sp == 3) {
                SchedPlain S; S.bid = obid(); S.A = (const char*)(ws + O_YCAT); S.B = (const char*)(wl + O_WOUT); S.K = 1024; S.total = 512; S.tm.init(128, 4);
                EpiY E; E.y = (bf16_t*)(ws + O_Y); E.rss = (float*)(ws + O_RSS);
                if (EN(7)) gemm_phase(lds, 1024, 1024, 1024, 1 << 30, 0, S, E);
            } else if (sp == 4) {
                if (l == 0) phase_rows<false>(p.in[I_X], nullptr, nullptr, (bf16_t*)(ws + O_XB), (const bf16_t*)(ws + O_Y), (const float*)(ws + O_RSS), modl, 2048, p.in[I_GPOSTMIX] + l * 1024, true,
                           true, modl, 3072, 4096, p.in[I_GPREFFN] + l * 1024, (bf16_t*)(ws + O_H));
                else phase_rows<true>(nullptr, (const bf16_t*)(ws + O_XB), nullptr, (bf16_t*)(ws + O_XB), (const bf16_t*)(ws + O_Y), (const float*)(ws + O_RSS), modl, 2048, p.in[I_GPOSTMIX] + l * 1024, true,
                           true, modl, 3072, 4096, p.in[I_GPREFFN] + l * 1024, (bf16_t*)(ws + O_H));
            } else if (sp == 5) {
                SchedPlain S; S.bid = obid(); S.A = (const char*)(ws + O_H); S.B = (const char*)(wl + O_WUP); S.K = 1024; S.total = 128 * 22; S.tm.init(128, 22);
                EpiUp E; E.act = (bf16_t*)(ws + O_ACT); E.edge = (bf16_t*)(ws + O_EDGE); E.cw = p.in[I_CONVW] + (size_t)l * 3 * 5632; E.cb = p.in[I_CONVB] + (size_t)l * 5632;
                if (EN(8)) gemm_phase(lds, 1024, 1024, 1024, 1 << 30, 0, S, E);
            } else if (sp == 6) { if (EN(9)) {
                const bf16_t* edge = (const bf16_t*)(ws + O_EDGE); bf16_t* act = (bf16_t*)(ws + O_ACT);
                const float* cw = p.in[I_CONVW] + (size_t)l * 3 * 5632; const float* cb = p.in[I_CONVB] + (size_t)l * 5632;
                for (int idx = obid() * NTHREADS + otid(); idx < 512 * 2 * 704; idx += gridDim.x * NTHREADS) {
                    const int c4 = (idx % 704) * 4, which = (idx / 704) & 1, seg = idx / 1408;
                    const int t = seg * 64 + (which ? 63 : 0);
                    const bf16_t* ec = edge + (size_t)(seg * 4 + (which ? 3 : 0)) * 2 * DFF;
                    const bf16_t* ep = which ? edge + (size_t)(seg * 4 + 2) * 2 * DFF : ((seg & 31) == 0 ? nullptr : edge + (size_t)((seg - 1) * 4 + 3) * 2 * DFF);
                    const bf16_t* en = which ? ((seg & 31) == 31 ? nullptr : edge + (size_t)((seg + 1) * 4 + 0) * 2 * DFF) : edge + (size_t)(seg * 4 + 1) * 2 * DFF;
                    const u32x2 z2 = {0u, 0u};
                    const u32x2 gpw = ep ? *(const u32x2*)(ep + c4) : z2, gcw = *(const u32x2*)(ec + c4), gnw = en ? *(const u32x2*)(en + c4) : z2;
                    const u32x2 vpw = ep ? *(const u32x2*)(ep + DFF + c4) : z2, vcw = *(const u32x2*)(ec + DFF + c4), vnw = en ? *(const u32x2*)(en + DFF + c4) : z2;
                    const f32x4 wg0 = *(const f32x4*)(cw + c4), wg1 = *(const f32x4*)(cw + 5632 + c4), wg2 = *(const f32x4*)(cw + 2 * 5632 + c4), bg = *(const f32x4*)(cb + c4);
                    const f32x4 wv0 = *(const f32x4*)(cw + 2816 + c4), wv1 = *(const f32x4*)(cw + 5632 + 2816 + c4), wv2 = *(const f32x4*)(cw + 2 * 5632 + 2816 + c4), bv = *(const f32x4*)(cb + 2816 + c4);
                    const f32x4 gp = {bf_lo(gpw.x), bf_hi(gpw.x), bf_lo(gpw.y), bf_hi(gpw.y)}, gc = {bf_lo(gcw.x), bf_hi(gcw.x), bf_lo(gcw.y), bf_hi(gcw.y)}, gn = {bf_lo(gnw.x), bf_hi(gnw.x), bf_lo(gnw.y), bf_hi(gnw.y)};
                    const f32x4 vp = {bf_lo(vpw.x), bf_hi(vpw.x), bf_lo(vpw.y), bf_hi(vpw.y)}, vc = {bf_lo(vcw.x), bf_hi(vcw.x), bf_lo(vcw.y), bf_hi(vcw.y)}, vn = {bf_lo(vnw.x), bf_hi(vnw.x), bf_lo(vnw.y), bf_hi(vnw.y)};
                    const f32x4 ug = wg0 * gp + wg1 * gc + wg2 * gn + bg, uv = wv0 * vp + wv1 * vc + wv2 * vn + bv;
                    float o[4];
#pragma unroll
                    for (int j = 0; j < 4; ++j) o[j] = gelu_tanh(ug[j]) * uv[j];
                    u32x2 w; w.x = pk_bf16(o[0], o[1]); w.y = pk_bf16(o[2], o[3]);
                    *(u32x2*)(act + (size_t)t * DFF + c4) = w;
                } }
            } else if (sp == 7) {
                SchedPlain S; S.bid = obid(); S.A = (const char*)(ws + O_ACT); S.B = (const char*)(wl + O_WDN); S.K = 2816; S.total = 512; S.tm.init(128, 4);
                EpiY E; E.y = (bf16_t*)(ws + O_Y); E.rss = (float*)(ws + O_RSS);
                if (EN(10)) gemm_phase(lds, 2816, 2816, 2816, 1 << 30, 0, S, E);
            } else {
                const bool has_next = (l + 1 < NL);
                const float* modn = mod + (size_t)(l + 1) * 16 * 6144;
                phase_rows<true>(nullptr, (const bf16_t*)(ws + O_XB), p.out, has_next ? (bf16_t*)(ws + O_XB) : nullptr, (const bf16_t*)(ws + O_Y), (const float*)(ws + O_RSS), modl, 5120, p.in[I_GPOSTFFN] + l * 1024, true,
                           has_next, modn, 0, 1024, p.in[I_GPREMIX] + (has_next ? (l + 1) * 1024 : 0), (bf16_t*)(ws + O_H));
            }
        }
        if (ph + 1 < ph_hi) { if (ph_hi < 0) grid.sync();   xcd_barrier((unsigned*)(ws + O_CTR + 1024), xst); }
    }
}

constexpr unsigned ALL_KINDS = 0x7ffu;
extern "C" void kernel_launch(void* const* d_in, const int* in_sizes, int n_in, void* d_out, int out_size, void* d_ws, size_t ws_size, hipStream_t stream) {
    static int grid_blocks = 0;
    if (!grid_blocks) {
        int dev = 0, cus = 0, per_cu = 0;
        (void)hipGetDevice(&dev);
        (void)hipDeviceGetAttribute(&cus, hipDeviceAttributeMultiprocessorCount, dev);
        (void)hipFuncSetAttribute((const void*)fwd_megakernel<ALL_KINDS>, hipFuncAttributeMaxDynamicSharedMemorySize, LDS_BYTES);
        (void)hipOccupancyMaxActiveBlocksPerMultiprocessor(&per_cu, fwd_megakernel<ALL_KINDS>, NTHREADS, LDS_BYTES);
        if (per_cu < 1) per_cu = 1;
        grid_blocks = cus * per_cu;
        if (grid_blocks > 256) grid_blocks = 256;
        if (grid_blocks < 8) grid_blocks = 8;
    }
    Params p{};
    for (int i = 0; i < 25; ++i) p.in[i] = (const float*)d_in[i];
    p.out = (float*)d_out; p.ws = (unsigned char*)d_ws; p.ph_lo = 0; p.ph_hi = NPHASE;
    (void)hipMemsetAsync((unsigned char*)d_ws + O_CTR, 0, 16384, stream);
    void* args[] = {&p};
    hipError_t e = hipLaunchCooperativeKernel((const void*)fwd_megakernel<ALL_KINDS>, dim3(grid_blocks), dim3(NTHREADS), args, LDS_BYTES, stream);
    if (e != hipSuccess) fprintf(stderr, "cooperative launch failed: %s (grid %d)\n", hipGetErrorString(e), grid_blocks);
}
```

```cpp
#include <hip/hip_runtime.h>
#include <hip/hip_cooperative_groups.h>
#include <cstdio>
namespace cg = cooperative_groups;

#define DI __device__ __forceinline__
#define LAS __attribute__((address_space(3)))
typedef unsigned short bf16_t;
typedef short bf16x8 __attribute__((ext_vector_type(8)));
typedef short s16x4 __attribute__((ext_vector_type(4)));
typedef float f32x2 __attribute__((ext_vector_type(2)));
typedef float f32x4 __attribute__((ext_vector_type(4)));
typedef float f32x16 __attribute__((ext_vector_type(16)));
typedef unsigned u32x2 __attribute__((ext_vector_type(2)));
typedef unsigned u32x4 __attribute__((ext_vector_type(4)));
typedef __bf16 nbf16x2 __attribute__((ext_vector_type(2)));

constexpr int MTOK = 32768, DM = 1024, SEQ = 2048, NB = 16, NL = 2, DFF = 2816;
constexpr int BM = 256, BK = 64, HALF = 128, HTB = HALF * BK * 2, STAGE_BYTES = 8 * HTB;
constexpr int LDS_BYTES = 155648;
constexpr int NTHREADS = 512;

constexpr size_t O_WIN = 0;
constexpr size_t O_WPQ = O_WIN + 1024ull * 1024 * 2;
constexpr size_t O_WGLU = O_WPQ + 512ull * 1024 * 2;
constexpr size_t O_WOUT = O_WGLU + 512ull * 384 * 2;
constexpr size_t O_WUP = O_WOUT + 1024ull * 1024 * 2;
constexpr size_t O_WDN = O_WUP + 5632ull * 1024 * 2;
constexpr size_t O_SA = O_WDN + 1024ull * 2816 * 2;
constexpr size_t O_SB = O_SA + 2ull * 24 * 2 * 64 * 4;
constexpr size_t O_SC = O_SB + 2ull * 24 * 4 * 64 * 8 * 2;
constexpr size_t O_CB = O_SC + 2ull * 24 * 8 * 64 * 8 * 2;
constexpr size_t LAYER_W = O_CB + 2ull * 24 * 64 * 8 * 2;
constexpr size_t O_DFT = 2 * LAYER_W;
constexpr size_t O_MOD = O_DFT + 2048ull * 4096 * 2;
constexpr size_t O_CTR = O_MOD + 2ull * 16 * 6144 * 4;
constexpr size_t O_H = O_CTR + 16384;
constexpr size_t O_Y = O_H + (size_t)MTOK * 1024 * 2;
constexpr size_t O_RSS = O_Y + (size_t)MTOK * 1024 * 2;
constexpr size_t O_Z = O_RSS + (size_t)MTOK * 16 * 4;
constexpr size_t O_PQT = O_Z + (size_t)MTOK * 1024 * 2;
constexpr size_t O_YPRE = O_PQT + 512ull * MTOK * 2;
constexpr size_t O_YCAT = O_YPRE + (size_t)MTOK * 384 * 2;
constexpr size_t O_EDGE = O_YCAT + (size_t)MTOK * 1024 * 2;
constexpr size_t O_UT = O_EDGE + 512ull * 4 * 5632 * 2;
constexpr size_t O_XB = O_UT + (size_t)MTOK * 384 * 2;
constexpr size_t O_END = O_XB + (size_t)MTOK * 1024 * 2;
constexpr size_t O_AB = O_H + 2ull * MTOK * 384 * 4;
static_assert(O_AB + 2ull * 16 * 1024 * 256 * 4 <= O_H + 2ull * MTOK * 1024 * 2, "ab alias");
constexpr size_t O_YFB = O_H;
constexpr size_t O_ACT = O_Z;
static_assert(2ull * MTOK * 384 * 4 <= 2ull * MTOK * 1024 * 2, "yfb alias");
static_assert((size_t)MTOK * 2816 * 2 <= O_EDGE - O_Z, "act alias");

struct Params {
    const float* in[25];
    float* out;
    unsigned char* ws;
    int ph_lo, ph_hi;
};
enum { I_X = 0, I_C, I_WADA, I_BADA, I_GPREMIX, I_GPOSTMIX, I_GPREFFN, I_GPOSTFFN, I_WIN, I_LAMRE, I_LAMIM, I_LOGDT, I_BRE, I_BIM, I_CRE, I_CIM,
       I_DSKIP, I_WGLU, I_WFFT, I_SINK, I_WOUT, I_WUP, I_CONVW, I_CONVB, I_WDOWN };

DI unsigned pk_bf16(float lo, float hi) {
    f32x2 v = {lo, hi};
    nbf16x2 b = __builtin_convertvector(v, nbf16x2);
    return __builtin_bit_cast(unsigned, b);
}
DI float bf_lo(unsigned w) { return __uint_as_float(w << 16); }
DI float bf_hi(unsigned w) { return __uint_as_float(w & 0xffff0000u); }
DI float bf2f(bf16_t b) { return __uint_as_float(((unsigned)b) << 16); }
DI bf16_t f2bf(float f) { return (bf16_t)(pk_bf16(f, 0.f) & 0xffffu); }
DI float gelu_tanh(float x) {
    float t = x * (1.0f + 0.044715f * x * x);
    float e = __builtin_amdgcn_exp2f(-2.302208198f * t);
    return x * __builtin_amdgcn_rcpf(1.0f + e);
}
DI float sigmoidf_(float x) { return __builtin_amdgcn_rcpf(1.0f + __builtin_amdgcn_exp2f(-1.442695041f * x)); }
DI bf16x8 pack8(float a0, float a1, float a2, float a3, float a4, float a5, float a6, float a7) {
    u32x4 w; w.x = pk_bf16(a0, a1); w.y = pk_bf16(a2, a3); w.z = pk_bf16(a4, a5); w.w = pk_bf16(a6, a7);
    return __builtin_bit_cast(bf16x8, w);
}
DI int otid() { int t = threadIdx.x; asm volatile("" : "+v"(t)); return t; }
DI int obid() { int b = blockIdx.x; asm volatile("" : "+s"(b)); return b; }
DI float bperm(float v, int srclane) { return __int_as_float(__builtin_amdgcn_ds_bpermute(srclane << 2, __float_as_int(v))); }
#define MFMA32(a, b, c) __builtin_amdgcn_mfma_f32_32x32x16_bf16((a), (b), (c), 0, 0, 0)

DI int lds_byte(int r, int c) { const int st = (r >> 4) * 2 + (c >> 5), rr = r & 15, cc = c & 31, ob = rr * 64 + cc * 2; return st * 1024 + (ob ^ (((ob >> 9) & 1) << 5)); }
DI void stage_rc(int b, int& R, int& C) { const int st = b / 1024, sb = b % 1024, swz = sb ^ (((sb >> 9) & 1) << 5); R = (st >> 1) * 16 + swz / 64; C = (st & 1) * 32 + (swz % 64) / 2; }
DI int perm32(int rho) { const int n = rho >> 4, i = rho & 15; return 8 * (i >> 2) + 4 * n + (i & 3); }

struct Unit { const char* A; const char* B; char* C; int ldc; int pm, pn; int kind; };
struct TileMap {
    int nM, nN, nwg;
    DI void init(int nM_, int nN_) { nM = nM_; nN = nN_; nwg = nM_ * nN_; }
    DI void get(int L, int& pm, int& pn) const {
        int wgid = L; { const int q = nwg / 8, r = nwg % 8, xcd = wgid % 8, off = wgid / 8; wgid = (xcd < r ? xcd * (q + 1) : r * (q + 1) + (xcd - r) * q) + off; }
        const int nig = 8 * nN, gid = wgid / nig, fm = gid * 8, gsz = (nM - fm) < 8 ? (nM - fm) : 8;
        pm = fm + ((wgid % nig) % gsz); pn = (wgid % nig) / gsz;
    }
};

template <class Epi, class Sched>
DI void gemm_phase(LAS unsigned char* lds, const int K, const int lda, const int ldb, const int jt, const long jumpB, Sched& S, const Epi& E) {
    const int tid = otid(), wid = __builtin_amdgcn_readfirstlane(tid >> 6), lane = tid & 63, wr = wid >> 2, wc = wid & 3, fr = lane & 15, fq = lane >> 4;
    const int nt = K / BK;
    unsigned voffA[2], voffB[2];
#pragma unroll
    for (int i = 0; i < 2; ++i) { int R, C; stage_rc(tid * 16 + i * 8192, R, C); const int Rb = (R >> 5) * 64 + perm32(R & 31);
        const int Ra = Epi::APERM ? ((R & ~63) + 4 * (R & 15) + ((R >> 4) & 3)) : R;
        voffA[i] = (unsigned)(Ra * lda + C) * 2u; voffB[i] = (unsigned)(Rb * ldb + C) * 2u; }
    const size_t kstep = (size_t)(BK * 2);
    const size_t hstepA = (size_t)HALF * lda * 2, hstepB = (size_t)32 * ldb * 2;
    const unsigned ldsw = (unsigned)wid * 1024u;
    const int aoff = lds_byte(wr * 64 + fr, fq * 8), boff = lds_byte(wc * 32 + fr, fq * 8);
#define PG8_SA(b, h) (((b) * 2 + (h)) * HTB)
#define PG8_SB(b, h) ((4 + (b) * 2 + (h)) * HTB)
#define PG8_STAGE(bufoff, gbase, voff) do { _Pragma("unroll") for (int _i = 0; _i < 2; ++_i) \
        __builtin_amdgcn_global_load_lds((const unsigned*)((const char*)(gbase) + (voff)[_i]), (LAS unsigned*)(lds + (bufoff) + ldsw + _i * 8192), 16, 0, 0); } while (0)
#define PG8_LDA(dst, b, h) do { _Pragma("unroll") for (int m = 0; m < 4; ++m) _Pragma("unroll") for (int k = 0; k < 2; ++k) dst[m][k] = *(const LAS bf16x8*)(lds + PG8_SA(b, h) + aoff + m * 2048 + k * 1024); } while (0)
#define PG8_LDB(dst, b, h) do { _Pragma("unroll") for (int n = 0; n < 2; ++n) _Pragma("unroll") for (int k = 0; k < 2; ++k) dst[n][k] = *(const LAS bf16x8*)(lds + PG8_SB(b, h) + boff + n * 2048 + k * 1024); } while (0)
#define PG8_MMA(ai, bj, At, Bt) do { __builtin_amdgcn_s_setprio(1); _Pragma("unroll") for (int m = 0; m < 4; ++m) _Pragma("unroll") for (int n = 0; n < 2; ++n) _Pragma("unroll") for (int k = 0; k < 2; ++k) \
        acc[ai][bj][m][n] = __builtin_amdgcn_mfma_f32_16x16x32_bf16(Bt[n][k], At[m][k], acc[ai][bj][m][n], 0, 0, 0); __builtin_amdgcn_s_setprio(0); } while (0)
#define PG8_WAIT_V(n) asm volatile("s_waitcnt vmcnt(" #n ")" ::: "memory")
#define PG8_WAIT_L(n) asm volatile("s_waitcnt lgkmcnt(" #n ")" ::: "memory")
#define PG8_BAR __builtin_amdgcn_s_barrier()
#define PG8_SCHED __builtin_amdgcn_sched_barrier(0)
    Unit cur, nxt; int ui = 0;
    if (!S.next(0, cur)) return;
    f32x4 acc[2][2][4][2];
#pragma unroll
    for (int a = 0; a < 2; ++a)
#pragma unroll
        for (int b = 0; b < 2; ++b)
#pragma unroll
            for (int m = 0; m < 4; ++m)
#pragma unroll
                for (int n = 0; n < 2; ++n) acc[a][b][m][n] = (f32x4){0.f, 0.f, 0.f, 0.f};
    bf16x8 At[4][2], B0[2][2], B1[2][2];
    const char* cA = cur.A; const char* cB = cur.B;
    E.begin(cur, lds);
    PG8_STAGE(PG8_SB(0, 0), cB, voffB); PG8_STAGE(PG8_SA(0, 0), cA, voffA); PG8_STAGE(PG8_SB(0, 1), cB + hstepB, voffB); PG8_STAGE(PG8_SA(0, 1), cA + hstepA, voffA);
    if (wr == 1) PG8_BAR;
    PG8_WAIT_V(4); PG8_BAR;
    PG8_STAGE(PG8_SB(1, 0), cB + kstep, voffB); PG8_STAGE(PG8_SA(1, 0), cA + kstep, voffA); PG8_STAGE(PG8_SB(1, 1), cB + hstepB + kstep, voffB);
    PG8_WAIT_V(6); PG8_BAR;
    for (;;) {
        const bool has_next = S.next(ui + 1, nxt);
        const char* nA = has_next ? nxt.A : cA; const char* nB = has_next ? nxt.B : cB;
#pragma unroll 1
        for (int t = 0; t < nt; t += 2) {
            const bool last = (t == nt - 2);
            const char* a1 = cA + (size_t)(t + 1) * kstep;
            const char* a2 = last ? nA : cA + (size_t)(t + 2) * kstep;
            const char* b2 = last ? nB : cB + (size_t)(t + 2) * kstep + ((t + 2) >= jt ? jumpB : 0);
            const char* a3 = a2 + kstep; const char* b3 = b2 + kstep;
            PG8_LDB(B0, 0, 0); PG8_SCHED; PG8_LDA(At, 0, 0); PG8_STAGE(PG8_SA(1, 1), a1 + hstepA, voffA);
            PG8_WAIT_L(8); PG8_BAR; PG8_WAIT_L(0); PG8_MMA(0, 0, At, B0); PG8_BAR; PG8_SCHED;
            PG8_LDB(B1, 0, 1); PG8_STAGE(PG8_SB(0, 0), b2, voffB);
            PG8_BAR; PG8_WAIT_L(0); PG8_MMA(0, 1, At, B1); PG8_BAR;
            PG8_LDA(At, 0, 1); PG8_STAGE(PG8_SA(0, 0), a2, voffA);
            PG8_BAR; PG8_WAIT_L(0); PG8_MMA(1, 0, At, B0); PG8_BAR; PG8_SCHED;
            PG8_STAGE(PG8_SB(0, 1), b2 + hstepB, voffB);
            PG8_WAIT_V(6); PG8_BAR; PG8_MMA(1, 1, At, B1); PG8_BAR;
            PG8_LDB(B0, 1, 0); PG8_SCHED; PG8_LDA(At, 1, 0); PG8_STAGE(PG8_SA(0, 1), a2 + hstepA, voffA);
            PG8_WAIT_L(8); PG8_BAR; PG8_WAIT_L(0); PG8_MMA(0, 0, At, B0); PG8_BAR; PG8_SCHED;
            PG8_LDB(B1, 1, 1); PG8_STAGE(PG8_SB(1, 0), b3, voffB);
            PG8_BAR; PG8_WAIT_L(0); PG8_MMA(0, 1, At, B1); PG8_BAR;
            PG8_LDA(At, 1, 1); PG8_STAGE(PG8_SA(1, 0), a3, voffA);
            PG8_BAR; PG8_WAIT_L(0); PG8_MMA(1, 0, At, B0); PG8_BAR; PG8_SCHED;
            PG8_STAGE(PG8_SB(1, 1), b3 + hstepB, voffB);
            PG8_WAIT_V(6); PG8_BAR; PG8_MMA(1, 1, At, B1); PG8_BAR;
        }
        E(acc, cur, nxt, has_next, ui, lds, wr, wc);
        if (!has_next) break;
#pragma unroll
        for (int a = 0; a < 2; ++a)
#pragma unroll
            for (int b = 0; b < 2; ++b)
#pragma unroll
                for (int m = 0; m < 4; ++m)
#pragma unroll
                    for (int n = 0; n < 2; ++n) acc[a][b][m][n] = (f32x4){0.f, 0.f, 0.f, 0.f};
        cur = nxt; cA = nA; cB = nB; ++ui;
    }
    PG8_WAIT_V(0);
    if (wr == 0) PG8_BAR;
    PG8_BAR;
#undef PG8_SA
#undef PG8_SB
#undef PG8_STAGE
#undef PG8_LDA
#undef PG8_LDB
#undef PG8_MMA
#undef PG8_WAIT_V
#undef PG8_WAIT_L
#undef PG8_BAR
#undef PG8_SCHED
}

typedef f32x4 Acc[2][2][4][2];
DI int opaque_lane() { int l; asm volatile("v_mbcnt_lo_u32_b32 %0, -1, 0\n\tv_mbcnt_hi_u32_b32 %0, -1, %0" : "=v"(l)); return l; }
struct EpiBf16 {
    static constexpr bool APERM = false;
    DI void begin(const Unit&, LAS unsigned char*) const {}
    DI void operator()(Acc& acc, const Unit& u, const Unit&, bool, int, LAS unsigned char*, int wr, int wc) const {
        const int lane_ = opaque_lane(), fr = lane_ & 15, fq = lane_ >> 4;
        bf16_t* base = (bf16_t*)u.C + (size_t)(wr * 64 + fr) * u.ldc + wc * 64 + 8 * fq;
#pragma unroll
        for (int ai = 0; ai < 2; ++ai)
#pragma unroll
            for (int m = 0; m < 4; ++m) { bf16_t* rowp = base + (size_t)(ai * HALF + m * 16) * u.ldc;
#pragma unroll
                for (int bj = 0; bj < 2; ++bj) { const f32x4 v0 = acc[ai][bj][m][0], v1 = acc[ai][bj][m][1];
                    u32x4 w; w.x = pk_bf16(v0[0], v0[1]); w.y = pk_bf16(v0[2], v0[3]); w.z = pk_bf16(v1[0], v1[1]); w.w = pk_bf16(v1[2], v1[3]);
                    __builtin_nontemporal_store(w, (u32x4*)(rowp + bj * 32)); } }
    }
};
struct EpiInproj {
    static constexpr bool APERM = false;
    bf16_t* ut;
    DI void begin(const Unit&, LAS unsigned char*) const {}
    DI void operator()(Acc& acc, const Unit& u, const Unit&, bool, int, LAS unsigned char*, int wr, int wc) const {
        const int lane_ = opaque_lane(), fr = lane_ & 15, fq = lane_ >> 4;
        bf16_t* base = (bf16_t*)u.C + (size_t)(wr * 64 + fr) * u.ldc + wc * 64 + 8 * fq;
#pragma unroll
        for (int ai = 0; ai < 2; ++ai)
#pragma unroll
            for (int m = 0; m < 4; ++m) { bf16_t* rowp = base + (size_t)(ai * HALF + m * 16) * u.ldc;
#pragma unroll
                for (int bj = 0; bj < 2; ++bj) { const f32x4 v0 = acc[ai][bj][m][0], v1 = acc[ai][bj][m][1];
                    u32x4 w; w.x = pk_bf16(v0[0], v0[1]); w.y = pk_bf16(v0[2], v0[3]); w.z = pk_bf16(v1[0], v1[1]); w.w = pk_bf16(v1[2], v1[3]);
                    if (u.kind == 0 && u.pn * BM + wc * 64 < 384) {
                        const int col = u.pn * BM + wc * 64 + bj * 32 + 8 * fq, t = u.pm * BM + ai * HALF + wr * 64 + m * 16 + fr;
                        const unsigned o = (unsigned)((((((t >> 11) * 24 + (col >> 4)) * 64 + (t & 63)) * 32 + ((t >> 6) & 31)) * 16) + (col & 8));
                        *(u32x4*)(ut + o) = w;
                    } else __builtin_nontemporal_store(w, (u32x4*)(rowp + bj * 32)); } }
    }
};
struct EpiF32 {
    static constexpr bool APERM = false;
    DI void begin(const Unit&, LAS unsigned char*) const {}
    DI void operator()(Acc& acc, const Unit& u, const Unit&, bool, int, LAS unsigned char*, int wr, int wc) const {
        const int lane_ = opaque_lane(), fr = lane_ & 15, fq = lane_ >> 4;
        float* base = (float*)u.C + (size_t)(wr * 64 + fr) * u.ldc + wc * 64 + 8 * fq;
#pragma unroll
        for (int ai = 0; ai < 2; ++ai)
#pragma unroll
            for (int m = 0; m < 4; ++m) { float* rowp = base + (size_t)(ai * HALF + m * 16) * u.ldc;
#pragma unroll
                for (int bj = 0; bj < 2; ++bj) { *(f32x4*)(rowp + bj * 32) = acc[ai][bj][m][0]; *(f32x4*)(rowp + bj * 32 + 4) = acc[ai][bj][m][1]; } }
    }
};
struct EpiGlu {
    static constexpr bool APERM = false;
    const bf16_t* ypre; bf16_t* ycat;
    DI void begin(const Unit&, LAS unsigned char*) const {}
    DI void operator()(Acc& acc, const Unit& u, const Unit&, bool, int, LAS unsigned char*, int wr, int wc) const {
#pragma unroll
        for (int ai = 0; ai < 2; ++ai)
#pragma unroll
            for (int bj = 0; bj < 2; ++bj)
#pragma unroll
                for (int m = 0; m < 4; ++m)
#pragma unroll
                    for (int n = 0; n < 2; ++n)
#pragma unroll
                        for (int j = 0; j < 4; ++j) acc[ai][bj][m][n][j] = sigmoidf_(acc[ai][bj][m][n][j]);
#pragma unroll
        for (int bj = 0; bj < 2; ++bj) {
            if (u.pn * BM + wc * 64 < 384) {
#pragma unroll
                for (int ai = 0; ai < 2; ++ai)
#pragma unroll
                    for (int m = 0; m < 4; ++m) {
                        const int lane_ = opaque_lane(), fr = lane_ & 15, fq = lane_ >> 4;
                        const unsigned row = (unsigned)(u.pm * BM + wr * 64 + fr + ai * HALF + m * 16), col = (unsigned)(u.pn * BM + wc * 64 + 8 * fq + bj * 32);
                        const u32x4 yp = *(const u32x4*)(ypre + (row * 384u + col));
                        const f32x4 v0 = acc[ai][bj][m][0], v1 = acc[ai][bj][m][1];
                        u32x4 w;
                        w.x = pk_bf16(bf_lo(yp.x) * v0[0], bf_hi(yp.x) * v0[1]);
                        w.y = pk_bf16(bf_lo(yp.y) * v0[2], bf_hi(yp.y) * v0[3]);
                        w.z = pk_bf16(bf_lo(yp.z) * v1[0], bf_hi(yp.z) * v1[1]);
                        w.w = pk_bf16(bf_lo(yp.w) * v1[2], bf_hi(yp.w) * v1[3]);
                        *(u32x4*)(ycat + (row * 1024u + col)) = w;
                    }
            }
        }
    }
};
struct EpiY {
    static constexpr bool APERM = false;
    bf16_t* y; float* rss;
    DI void begin(const Unit&, LAS unsigned char*) const {}
    DI void operator()(Acc& acc, const Unit& u, const Unit&, bool, int, LAS unsigned char*, int wr, int wc) const {
        const int lane_ = opaque_lane(), fr = lane_ & 15, fq = lane_ >> 4;
        const int row0 = u.pm * BM + wr * 64 + fr, col0 = u.pn * BM + wc * 64 + 8 * fq;
#pragma unroll
        for (int ai = 0; ai < 2; ++ai)
#pragma unroll
            for (int m = 0; m < 4; ++m) { const size_t row = (size_t)(row0 + ai * HALF + m * 16); float s = 0.f;
#pragma unroll
                for (int bj = 0; bj < 2; ++bj) { const f32x4 v0 = acc[ai][bj][m][0], v1 = acc[ai][bj][m][1];
                    s += (v0[0] * v0[0] + v0[1] * v0[1]) + (v0[2] * v0[2] + v0[3] * v0[3]) + (v1[0] * v1[0] + v1[1] * v1[1]) + (v1[2] * v1[2] + v1[3] * v1[3]);
                    u32x4 w; w.x = pk_bf16(v0[0], v0[1]); w.y = pk_bf16(v0[2], v0[3]); w.z = pk_bf16(v1[0], v1[1]); w.w = pk_bf16(v1[2], v1[3]);
                    __builtin_nontemporal_store(w, (u32x4*)(y + row * 1024 + col0 + bj * 32)); }
                s += bperm(s, lane_ ^ 16); s += bperm(s, lane_ ^ 32);
                if (fq == 0) rss[row * 16 + u.pn * 4 + wc] = s; }
    }
};
DI float dpp_prev(float cur, float prevreg) {
    const int t = __builtin_amdgcn_update_dpp(0, __float_as_int(prevreg), 0x121, 0xf, 0xf, false);
    return __int_as_float(__builtin_amdgcn_update_dpp(t, __float_as_int(cur), 0x111, 0xf, 0xf, false));
}
DI float dpp_next(float cur, float nextreg) {
    const int t = __builtin_amdgcn_update_dpp(0, __float_as_int(nextreg), 0x12f, 0xf, 0xf, false);
    return __int_as_float(__builtin_amdgcn_update_dpp(t, __float_as_int(cur), 0x101, 0xf, 0xf, false));
}
DI f32x4 dpp_shr1_v(const f32x4 v) { f32x4 r;
#pragma unroll
    for (int j = 0; j < 4; ++j) r[j] = __int_as_float(__builtin_amdgcn_update_dpp(__float_as_int(v[j]), __float_as_int(v[j]), 0x111, 0xf, 0xf, false));
    return r; }
DI f32x4 dpp_shl1_v(const f32x4 v) { f32x4 r;
#pragma unroll
    for (int j = 0; j < 4; ++j) r[j] = __int_as_float(__builtin_amdgcn_update_dpp(__float_as_int(v[j]), __float_as_int(v[j]), 0x101, 0xf, 0xf, false));
    return r; }
struct EpiUp {
    static constexpr bool APERM = true;
    bf16_t* act; bf16_t* edge; const float* cw; const float* cb;
    DI float ldw(const Unit& u, int idx) const { const int arr = idx >> 8, col = idx & 255, chn = (col >> 7) * 2816 + u.pn * 128 + (col & 127); return arr < 3 ? cw[arr * 5632 + chn] : cb[chn]; }
    DI void begin(const Unit& u, LAS unsigned char* lds) const {
        const int t = otid(); LAS float* wb = (LAS float*)(lds + STAGE_BYTES);
        wb[t] = ldw(u, t); wb[t + 512] = ldw(u, t + 512);
    }
    DI void operator()(Acc& acc, const Unit& u, const Unit& nx, bool has_next, int ui, LAS unsigned char* lds, int wr, int wc) const {
        const int t_ = otid();
        float pa = 0.f, pb = 0.f;
        if (has_next) { pa = ldw(nx, t_); pb = ldw(nx, t_ + 512); }
        const LAS float* wb = (const LAS float*)(lds + STAGE_BYTES) + (ui & 1) * 1024;
        {
            const int l_ = opaque_lane(), fr = l_ & 15, ch0 = u.pn * 128 + wc * 32 + 8 * (l_ >> 4);
            if (fr == 0 || fr == 15) {
                const int slot0 = fr == 0 ? 0 : 2;
#pragma unroll
                for (int ai = 0; ai < 2; ++ai) { const int seg = u.pm * 4 + ai * 2 + wr;
#pragma unroll
                    for (int bj = 0; bj < 2; ++bj)
#pragma unroll
                        for (int n = 0; n < 2; ++n) {
                            const f32x4 a = fr == 0 ? acc[ai][bj][0][n] : acc[ai][bj][2][n], b = fr == 0 ? acc[ai][bj][1][n] : acc[ai][bj][3][n];
                            u32x2 g2; g2.x = pk_bf16(a[0], a[1]); g2.y = pk_bf16(a[2], a[3]);
                            u32x2 h2; h2.x = pk_bf16(b[0], b[1]); h2.y = pk_bf16(b[2], b[3]);
                            *(u32x2*)(edge + (unsigned)(((seg * 4 + slot0) * 2 + bj) * DFF + ch0 + 4 * n)) = g2;
                            *(u32x2*)(edge + (unsigned)(((seg * 4 + slot0 + 1) * 2 + bj) * DFF + ch0 + 4 * n)) = h2; } }
            }
        }
#pragma unroll
        for (int bj = 0; bj < 2; ++bj)
#pragma unroll
            for (int n = 0; n < 2; ++n) {
                const int l_ = opaque_lane();
                const int wi = bj * 128 + wc * 32 + 8 * (l_ >> 4) + 4 * n;
                const f32x4 w0 = *(const LAS f32x4*)(wb + wi), w1 = *(const LAS f32x4*)(wb + 256 + wi), w2 = *(const LAS f32x4*)(wb + 512 + wi), bb = *(const LAS f32x4*)(wb + 768 + wi);
#pragma unroll
                for (int ai = 0; ai < 2; ++ai) {
                    const f32x4 X0 = acc[ai][bj][0][n], X1 = acc[ai][bj][1][n], X2 = acc[ai][bj][2][n], X3 = acc[ai][bj][3][n];
                    const f32x4 P = dpp_shr1_v(X3), N = dpp_shl1_v(X0);
                    f32x4 Y0 = w0 * P + w1 * X0 + w2 * X1 + bb, Y1 = w0 * X0 + w1 * X1 + w2 * X2 + bb, Y2 = w0 * X1 + w1 * X2 + w2 * X3 + bb, Y3 = w0 * X2 + w1 * X3 + w2 * N + bb;
                    if (bj == 0) {
#pragma unroll
                        for (int j = 0; j < 4; ++j) { Y0[j] = gelu_tanh(Y0[j]); Y1[j] = gelu_tanh(Y1[j]); Y2[j] = gelu_tanh(Y2[j]); Y3[j] = gelu_tanh(Y3[j]); }
                    }
                    acc[ai][bj][0][n] = Y0; acc[ai][bj][1][n] = Y1; acc[ai][bj][2][n] = Y2; acc[ai][bj][3][n] = Y3;
                }
                asm volatile("" ::: "memory");
            }
        {
            const int l_ = opaque_lane(), fr = l_ & 15, ch0 = u.pn * 128 + wc * 32 + 8 * (l_ >> 4);
#pragma unroll
            for (int ai = 0; ai < 2; ++ai)
#pragma unroll
                for (int m = 0; m < 4; ++m) {
                    const unsigned row = (unsigned)(u.pm * BM + ai * HALF + wr * 64 + 4 * fr + m);
                    const f32x4 g0 = acc[ai][0][m][0], v0 = acc[ai][1][m][0], g1 = acc[ai][0][m][1], v1 = acc[ai][1][m][1];
                    u32x4 w; w.x = pk_bf16(g0[0] * v0[0], g0[1] * v0[1]); w.y = pk_bf16(g0[2] * v0[2], g0[3] * v0[3]);
                    w.z = pk_bf16(g1[0] * v1[0], g1[1] * v1[1]); w.w = pk_bf16(g1[2] * v1[2], g1[3] * v1[3]);
                    __builtin_nontemporal_store(w, (u32x4*)(act + (row * (unsigned)DFF + (unsigned)ch0)));
                }
        }
        if (has_next) { LAS float* wn = (LAS float*)(lds + STAGE_BYTES) + ((ui + 1) & 1) * 1024; wn[t_] = pa; wn[t_ + 512] = pb; }
    }
};

struct SchedInproj {
    const char* h; const char* win; const char* wpq; char* z; char* pqt; TileMap m1, m2; int bid;
    DI bool next(int i, Unit& u) const {
        const int L = i * (int)gridDim.x + bid; if (L >= 768) return false;
        int pm, pn;
        if (L < 512) { m1.get(L, pm, pn); u.A = h + (size_t)pm * 256 * 1024 * 2; u.B = win + (size_t)pn * 256 * 1024 * 2; u.C = z + ((size_t)pm * 256 * 1024 + pn * 256) * 2; u.ldc = 1024; u.kind = 0; }
        else { m2.get(L - 512, pm, pn); u.A = wpq + (size_t)pm * 256 * 1024 * 2; u.B = h + (size_t)pn * 256 * 1024 * 2; u.C = pqt + ((size_t)pm * 256 * MTOK + pn * 256) * 2; u.ldc = MTOK; u.kind = 1; }
        u.pm = pm; u.pn = pn; return true;
    }
};
struct SchedPlain {
    const char* A; const char* B; int K; int total; TileMap tm; int bid;
    DI bool next(int i, Unit& u) const {
        const int L = i * (int)gridDim.x + bid; if (L >= total) return false;
        int pm, pn; tm.get(L, pm, pn);
        u.A = A + (size_t)pm * 256 * K * 2; u.B = B + (size_t)pn * 256 * K * 2; u.C = nullptr; u.ldc = 0; u.pm = pm; u.pn = pn; u.kind = 0; return true;
    }
};
struct SchedOne { Unit u0; DI bool next(int i, Unit& u) const { if (i > 0) return false; u = u0; return true; } };

DI void tconv_tile(LAS float* tile, const float* src, int ld_src, int k0, int srccol, bf16_t* dst, int ldd, int n0, int srccol_hi = -2) {
    const int tid = otid();
    __syncthreads();
#pragma unroll
    for (int i = 0; i < 8; ++i) { const int k = (tid >> 6) + 8 * i, n = tid & 63;
        const int sc2 = (srccol_hi != -2 && n >= 32) ? srccol_hi + (n - 32) : srccol + n;
        tile[k * 65 + n] = srccol >= 0 ? src[(size_t)(k0 + k) * ld_src + sc2] : 0.f; }
    __syncthreads();
    const int n = tid >> 3, kc = (tid & 7) * 8;
    float v[8];
#pragma unroll
    for (int j = 0; j < 8; ++j) v[j] = tile[(kc + j) * 65 + n];
    u32x4 w; w.x = pk_bf16(v[0], v[1]); w.y = pk_bf16(v[2], v[3]); w.z = pk_bf16(v[4], v[5]); w.w = pk_bf16(v[6], v[7]);
    *(u32x4*)(dst + (size_t)(n0 + n) * ldd + k0 + kc) = w;
}

DI void phase_prep(const Params& p, LAS unsigned char* lds) {
    const int tid = otid(), nblk = gridDim.x, bid = obid();
    LAS float* tile = (LAS float*)lds;
    for (int l = 0; l < NL; ++l) {
        unsigned char* wl = p.ws + l * LAYER_W;
        const float* w_in = p.in[I_WIN] + (size_t)l * 1024 * 1280;
        const float* w_glu = p.in[I_WGLU] + (size_t)l * 384 * 384;
        const float* w_out = p.in[I_WOUT] + (size_t)l * 1024 * 1024;
        const float* w_up = p.in[I_WUP] + (size_t)l * 1024 * 5632;
        const float* w_dn = p.in[I_WDOWN] + (size_t)l * 2816 * 1024;
        const float* w_fft = p.in[I_WFFT] + (size_t)l * 4 * 64 * 64;
        for (int j = bid; j < 2608; j += nblk) {
            if (j < 256) { const int kc = j >> 4, nc = j & 15; tconv_tile(tile, w_in, 1280, kc * 64, (nc < 6 ? nc : nc + 4) * 64, (bf16_t*)(wl + O_WIN), 1024, nc * 64); }
            else if (j < 304) { const int q = j - 256, kc = q >> 3, nc = q & 7; tconv_tile(tile, w_glu, 384, kc * 64, nc < 6 ? nc * 64 : -1, (bf16_t*)(wl + O_WGLU), 384, nc * 64); }
            else if (j < 496) { const int q = j - 304; int kc = q >> 4; const int nc = q & 15; kc = kc < 6 ? kc : kc + 4; tconv_tile(tile, w_out, 1024, kc * 64, nc * 64, (bf16_t*)(wl + O_WOUT), 1024, nc * 64); }
            else if (j < 1904) { const int q = j - 496, kc = q / 88, nc = q % 88, pn = nc >> 2, w4 = nc & 3;
                tconv_tile(tile, w_up, 5632, kc * 64, pn * 128 + w4 * 32, (bf16_t*)(wl + O_WUP), 1024, nc * 64, 2816 + pn * 128 + w4 * 32); }
            else { const int q = j - 1904, kc = q >> 4, nc = q & 15; tconv_tile(tile, w_dn, 1024, kc * 64, nc * 64, (bf16_t*)(wl + O_WDN), 2816, nc * 64); }
        }
        for (int j = (bid + nblk - 64 - 128 * l) % nblk; j < 64; j += nblk) {
            const int kc = j >> 2, hh = j & 3;
            __syncthreads();
#pragma unroll
            for (int i = 0; i < 8; ++i) { const int k = (tid >> 6) + 8 * i, d = tid & 63; tile[k * 65 + d] = w_in[(size_t)(kc * 64 + k) * 1280 + 384 + hh * 64 + d]; }
            LAS float* tab = tile + 64 * 65;
            if (tid < 64) { float s, c; sincospif((float)tid / 32.0f, &s, &c); tab[tid] = c * 0.125f; tab[64 + tid] = s * 0.125f; }
            __syncthreads();
            const int r = tid >> 2, part = r >> 6, e = r & 63, kg = (tid & 3) * 16;
            float o[16];
#pragma unroll
            for (int q = 0; q < 16; ++q) o[q] = 0.f;
            for (int d = 0; d < 64; ++d) { const float tv = tab[part * 64 + ((d * e) & 63)];
#pragma unroll
                for (int q = 0; q < 16; ++q) o[q] += tile[(kg + q) * 65 + d] * tv; }
            bf16_t* dst = (bf16_t*)(wl + O_WPQ) + (size_t)(part * 256 + hh * 64 + e) * 1024 + kc * 64 + kg;
            u32x4 w0, w1; w0.x = pk_bf16(o[0], o[1]); w0.y = pk_bf16(o[2], o[3]); w0.z = pk_bf16(o[4], o[5]); w0.w = pk_bf16(o[6], o[7]);
            w1.x = pk_bf16(o[8], o[9]); w1.y = pk_bf16(o[10], o[11]); w1.z = pk_bf16(o[12], o[13]); w1.w = pk_bf16(o[14], o[15]);
            *(u32x4*)dst = w0; *(u32x4*)(dst + 8) = w1;
        }
        for (int j = (bid + nblk - 128 - 128 * l + 2 * nblk) % nblk; j < 64; j += nblk) {
            const int hh = j >> 4, nc = j & 15;
            LAS float* tf = tile + 64 * 65;
            __syncthreads();
#pragma unroll
            for (int i = 0; i < 8; ++i) { const int e = (tid >> 6) + 8 * i, n = tid & 63;
                tile[e * 65 + n] = w_out[(size_t)(384 + hh * 64 + e) * 1024 + nc * 64 + n];
                tf[e * 65 + n] = w_fft[(size_t)hh * 4096 + e * 64 + n]; }
            __syncthreads();
            const int n = tid >> 3, dg = (tid & 7) * 8;
            float o[8];
#pragma unroll
            for (int q = 0; q < 8; ++q) o[q] = 0.f;
            for (int e = 0; e < 64; ++e) { const float wv = tile[e * 65 + n];
#pragma unroll
                for (int q = 0; q < 8; ++q) o[q] += tf[(dg + q) * 65 + e] * wv; }
            u32x4 w; w.x = pk_bf16(o[0], o[1]); w.y = pk_bf16(o[2], o[3]); w.z = pk_bf16(o[4], o[5]); w.w = pk_bf16(o[6], o[7]);
            *(u32x4*)((bf16_t*)(wl + O_WOUT) + (size_t)(nc * 64 + n) * 1024 + 384 + hh * 64 + dg) = w;
        }
        {
            const float* lam_re = p.in[I_LAMRE] + (size_t)l * 2 * 24 * 64; const float* lam_im = p.in[I_LAMIM] + (size_t)l * 2 * 24 * 64;
            const float* log_dt = p.in[I_LOGDT] + (size_t)l * 2 * 24;
            const float* b_re = p.in[I_BRE] + (size_t)l * 2 * 24 * 64 * 16; const float* b_im = p.in[I_BIM] + (size_t)l * 2 * 24 * 64 * 16;
            const float* c_re = p.in[I_CRE] + (size_t)l * 24 * 16 * 64; const float* c_im = p.in[I_CIM] + (size_t)l * 24 * 16 * 64;
            float* sa = (float*)(wl + O_SA); bf16_t* sb = (bf16_t*)(wl + O_SB); bf16_t* sc = (bf16_t*)(wl + O_SC);
            for (int idx = bid * NTHREADS + tid; idx < 2 * 24 * 64; idx += nblk * NTHREADS) {
                const int pp = idx & 63, g = (idx >> 6) % 24, dir = idx / (64 * 24);
                const float lr = lam_re[idx], li = lam_im[idx], dt = expf(log_dt[dir * 24 + g]);
                const float mag = expf(lr * dt); float sn, cs; sincosf(li * dt, &sn, &cs);
                const float ar = mag * cs, ai = mag * sn;
                sa[((dir * 24 + g) * 2 + 0) * 64 + pp] = ar; sa[((dir * 24 + g) * 2 + 1) * 64 + pp] = ai;
                const float xr = ar - 1.0f, xi = ai, den = 1.0f / (lr * lr + li * li);
                const float fr_ = (xr * lr + xi * li) * den, fi_ = (xi * lr - xr * li) * den;
                for (int ch = 0; ch < 16; ++ch) {
                    const float br = b_re[(size_t)idx * 16 + ch], bi = b_im[(size_t)idx * 16 + ch];
                    const float vr = fr_ * br - fi_ * bi, vi = fr_ * bi + fi_ * br;
                    const int lane = (pp & 31) + 32 * (ch >> 3), j = ch & 7, pt = pp >> 5;
                    sb[((size_t)((dir * 24 + g) * 4 + 0 + pt) * 64 + lane) * 8 + j] = f2bf(vr);
                    sb[((size_t)((dir * 24 + g) * 4 + 2 + pt) * 64 + lane) * 8 + j] = f2bf(vi);
                }
                {
                    const int pt = pp >> 5, p5 = pp & 31, s = p5 >> 4, rem = p5 & 15, hh = (rem >> 2) & 1, j = ((rem >> 3) << 2) | (rem & 3);
                    for (int r = 0; r < 32; ++r) {
                        const float c_r = c_re[((size_t)g * 16 + (r & 15)) * 64 + pp], c_i = c_im[((size_t)g * 16 + (r & 15)) * 64 + pp];
                        const float cr = r < 16 ? c_r : c_r * ar - c_i * ai, ci = r < 16 ? -c_i : -(c_r * ai + c_i * ar);
                        const int lane = r + 32 * hh;
                        sc[((size_t)(((dir * 24 + g) * 4 + 0 + pt) * 2 + s) * 64 + lane) * 8 + j] = f2bf(cr);
                        sc[((size_t)(((dir * 24 + g) * 4 + 2 + pt) * 2 + s) * 64 + lane) * 8 + j] = f2bf(ci);
                    }
                }
            }
            bf16_t* cbt = (bf16_t*)(wl + O_CB);
            {
                const int lane_ = tid & 63;
                for (int w = bid * 8 + (tid >> 6); w < 2 * 24 * 256; w += nblk * 8) {
                    const int c = w & 15, ch = (w >> 4) & 15, g = (w >> 8) % 24, dir = w / (256 * 24);
                    const int li = (dir * 24 + g) * 64 + lane_;
                    const float dt = expf(log_dt[dir * 24 + g]), lr = lam_re[li], li_ = lam_im[li];
                    const float mag = expf(lr * dt); float sn, cs; sincosf(li_ * dt, &sn, &cs);
                    const float xr = mag * cs - 1.0f, xi = mag * sn, den = 1.0f / (lr * lr + li_ * li_);
                    const float f_r = (xr * lr + xi * li_) * den, f_i = (xi * lr - xr * li_) * den;
                    const float br = b_re[(size_t)li * 16 + c], bi = b_im[(size_t)li * 16 + c];
                    const float vr = f_r * br - f_i * bi, vi = f_r * bi + f_i * br;
                    float acc = c_re[((size_t)g * 16 + ch) * 64 + lane_] * vr - c_im[((size_t)g * 16 + ch) * 64 + lane_] * vi;
                    acc += bperm(acc, lane_ ^ 32); acc += bperm(acc, lane_ ^ 16); acc += bperm(acc, lane_ ^ 8); acc += bperm(acc, lane_ ^ 4); acc += bperm(acc, lane_ ^ 2); acc += bperm(acc, lane_ ^ 1);
                    if (lane_ == 0) { const size_t base = ((size_t)(dir * 24 + g) * 64 + 32 * (c >> 3)) * 8 + (c & 7);
                        cbt[base + (size_t)(16 + ch) * 8] = f2bf(acc); cbt[base + (size_t)ch * 8] = 0; }
                }
            }
        }
    }
    {
        bf16_t* dft = (bf16_t*)(p.ws + O_DFT);
        const float sc_ = 0.02209708691f;
        for (int idx = bid * NTHREADS + tid; idx < 2048 * 256; idx += nblk * NTHREADS) {
            const int row = idx >> 8, k8 = (idx & 255) * 8, j = (row & 1023) + 1;
            float v[8];
#pragma unroll
            for (int q = 0; q < 8; ++q) { const int m = (j * (k8 + q)) & 2047; float sn, cs; sincospif((float)m * (1.0f / 1024.0f), &sn, &cs); v[q] = (row < 1024 ? cs : sn) * sc_; }
            u32x4 w; w.x = pk_bf16(v[0], v[1]); w.y = pk_bf16(v[2], v[3]); w.z = pk_bf16(v[4], v[5]); w.w = pk_bf16(v[6], v[7]);
            *(u32x4*)(dft + (size_t)row * 2048 + k8) = w;
        }
    }
    {
        float* mod = (float*)(p.ws + O_MOD);
        LAS float* cl = (LAS float*)lds;
        LAS float* red = cl + 16 * 1024;
        for (int j = (bid + nblk - 32) % nblk; j < 192; j += nblk) {
            const int l = j / 96, c0 = (j % 96) * 64;
            __syncthreads();
            for (int i = tid; i < 16 * 1024; i += NTHREADS) cl[i] = p.in[I_C][i];
            __syncthreads();
            const int kg = tid >> 6, col = tid & 63;
            const float* w = p.in[I_WADA] + (size_t)l * 1024 * 6144 + c0 + col;
            float a[16];
#pragma unroll
            for (int b = 0; b < 16; ++b) a[b] = 0.f;
            for (int k0 = kg * 128; k0 < kg * 128 + 128; k0 += 16) {
                float wv[16];
#pragma unroll
                for (int q = 0; q < 16; ++q) wv[q] = w[(size_t)(k0 + q) * 6144];
#pragma unroll
                for (int q = 0; q < 16; ++q)
#pragma unroll
                    for (int b = 0; b < 16; ++b) a[b] += cl[b * 1024 + k0 + q] * wv[q];
            }
#pragma unroll
            for (int b = 0; b < 16; ++b) red[(kg * 16 + b) * 64 + col] = a[b];
            __syncthreads();
            for (int o = tid; o < 16 * 64; o += NTHREADS) { const int b = o >> 6, cc = o & 63; float s = p.in[I_BADA][l * 6144 + c0 + cc];
#pragma unroll
                for (int q = 0; q < 8; ++q) s += red[(q * 16 + b) * 64 + cc];
                mod[((size_t)l * 16 + b) * 6144 + c0 + cc] = s; }
        }
    }
}

DI float wave_sum(float v, int lane) {
    v += bperm(v, lane ^ 32); v += bperm(v, lane ^ 16); v += bperm(v, lane ^ 8); v += bperm(v, lane ^ 4); v += bperm(v, lane ^ 2); v += bperm(v, lane ^ 1); return v; }
template <bool XB>
DI void phase_rows(const float* xin, const bf16_t* xin_b, float* xout, bf16_t* xout_b, const bf16_t* y, const float* rss, const float* modr, int gate_off, const float* g_post, bool do_res,
                   bool do_h, const float* modh, int sh_off, int sc_off, const float* g_pre, bf16_t* hout) {
    const int tid_ = otid(), lane = tid_ & 63, wid = tid_ >> 6;
#define RCOL(i) (lane * 8 + 512 * ((i) >> 1) + 4 * ((i) & 1))
    f32x4 gp[4], gq[4];
#pragma unroll
    for (int i = 0; i < 4; ++i) { const int c = RCOL(i); gp[i] = do_res ? *(const f32x4*)(g_post + c) : (f32x4){0.f, 0.f, 0.f, 0.f}; gq[i] = do_h ? *(const f32x4*)(g_pre + c) : (f32x4){0.f, 0.f, 0.f, 0.f}; }
    const int rstride = (int)gridDim.x * 32;
    u32x4 xr[4][2], yr[4][2]; float rsr[4];
#define ROWS_LOAD_RAW(R0) do { _Pragma("unroll") for (int r = 0; r < 4; ++r) { _Pragma("unroll") for (int h = 0; h < 2; ++h) { \
        xr[r][h] = *(const u32x4*)(xin_b + (size_t)((R0) + r) * 1024 + lane * 8 + 512 * h); yr[r][h] = *(const u32x4*)(y + (size_t)((R0) + r) * 1024 + lane * 8 + 512 * h); } \
        rsr[r] = rss[(size_t)((R0) + r) * 16 + (lane & 15)]; } } while (0)
    const int row_first = (obid() * 8 + wid) * 4;
    if (XB) { if (row_first < MTOK) ROWS_LOAD_RAW(row_first); }
    for (int row0 = row_first; row0 < MTOK; row0 += rstride) {
        const int b = row0 >> 11;
        f32x4 x[4][4]; u32x4 yw[4][2]; float rs[4];
        if (XB) {
#pragma unroll
            for (int r = 0; r < 4; ++r) {
#pragma unroll
                for (int h = 0; h < 2; ++h) { const u32x4 w = xr[r][h]; yw[r][h] = yr[r][h];
                    x[r][2 * h] = (f32x4){bf_lo(w.x), bf_hi(w.x), bf_lo(w.y), bf_hi(w.y)}; x[r][2 * h + 1] = (f32x4){bf_lo(w.z), bf_hi(w.z), bf_lo(w.w), bf_hi(w.w)}; }
                rs[r] = rsr[r]; }
            if (row0 + rstride < MTOK) ROWS_LOAD_RAW(row0 + rstride);
        } else {
#pragma unroll
            for (int r = 0; r < 4; ++r)
#pragma unroll
                for (int i = 0; i < 4; ++i) x[r][i] = *(const f32x4*)(xin + (size_t)(row0 + r) * 1024 + RCOL(i));
        }
        if (do_res) {
            if (!XB) {
#pragma unroll
                for (int r = 0; r < 4; ++r) {
#pragma unroll
                    for (int h = 0; h < 2; ++h) yw[r][h] = *(const u32x4*)(y + (size_t)(row0 + r) * 1024 + lane * 8 + 512 * h);
                    rs[r] = rss[(size_t)(row0 + r) * 16 + (lane & 15)];
                }
            }
            float rstdy[4];
#pragma unroll
            for (int r = 0; r < 4; ++r) { float ss = rs[r]; ss += bperm(ss, lane ^ 1); ss += bperm(ss, lane ^ 2); ss += bperm(ss, lane ^ 4); ss += bperm(ss, lane ^ 8); rstdy[r] = rsqrtf(ss * (1.0f / 1024.0f) + 1e-6f); }
#pragma unroll
            for (int h = 0; h < 2; ++h) {
                const f32x4 gt0 = *(const f32x4*)(modr + (size_t)b * 6144 + gate_off + RCOL(2 * h)) * gp[2 * h], gt1 = *(const f32x4*)(modr + (size_t)b * 6144 + gate_off + RCOL(2 * h + 1)) * gp[2 * h + 1];
#pragma unroll
                for (int r = 0; r < 4; ++r) {
                    const u32x4 w = yw[r][h]; const float rstd = rstdy[r];
                    f32x4& a = x[r][2 * h]; f32x4& c2 = x[r][2 * h + 1];
                    a[0] += gt0[0] * (bf_lo(w.x) * rstd); a[1] += gt0[1] * (bf_hi(w.x) * rstd); a[2] += gt0[2] * (bf_lo(w.y) * rstd); a[3] += gt0[3] * (bf_hi(w.y) * rstd);
                    c2[0] += gt1[0] * (bf_lo(w.z) * rstd); c2[1] += gt1[1] * (bf_hi(w.z) * rstd); c2[2] += gt1[2] * (bf_lo(w.w) * rstd); c2[3] += gt1[3] * (bf_hi(w.w) * rstd);
                    if (xout_b) { u32x4 o; o.x = pk_bf16(a[0], a[1]); o.y = pk_bf16(a[2], a[3]); o.z = pk_bf16(c2[0], c2[1]); o.w = pk_bf16(c2[2], c2[3]);
                        *(u32x4*)(xout_b + (size_t)(row0 + r) * 1024 + lane * 8 + 512 * h) = o;
                        a = (f32x4){bf_lo(o.x), bf_hi(o.x), bf_lo(o.y), bf_hi(o.y)}; c2 = (f32x4){bf_lo(o.z), bf_hi(o.z), bf_lo(o.w), bf_hi(o.w)}; }
                    else { *(f32x4*)(xout + (size_t)(row0 + r) * 1024 + RCOL(2 * h)) = a; *(f32x4*)(xout + (size_t)(row0 + r) * 1024 + RCOL(2 * h + 1)) = c2; }
                }
            }
        }
        if (do_h) {
            float rstd[4];
#pragma unroll
            for (int r = 0; r < 4; ++r) { float ss = 0.f;
#pragma unroll
                for (int i = 0; i < 4; ++i) ss += (x[r][i][0] * x[r][i][0] + x[r][i][1] * x[r][i][1]) + (x[r][i][2] * x[r][i][2] + x[r][i][3] * x[r][i][3]);
                rstd[r] = rsqrtf(wave_sum(ss, lane) * (1.0f / 1024.0f) + 1e-6f); }
#pragma unroll
            for (int h = 0; h < 2; ++h) {
                f32x4 gg[2], sh[2];
#pragma unroll
                for (int q = 0; q < 2; ++q) { const int c = RCOL(2 * h + q);
                    const f32x4 sc = *(const f32x4*)(modh + (size_t)b * 6144 + sc_off + c); sh[q] = *(const f32x4*)(modh + (size_t)b * 6144 + sh_off + c); gg[q] = gq[2 * h + q] * (sc + 1.0f); }
#pragma unroll
                for (int r = 0; r < 4; ++r) {
                    const f32x4 a = x[r][2 * h] * rstd[r] * gg[0] + sh[0], c2 = x[r][2 * h + 1] * rstd[r] * gg[1] + sh[1];
                    u32x4 o; o.x = pk_bf16(a[0], a[1]); o.y = pk_bf16(a[2], a[3]); o.z = pk_bf16(c2[0], c2[1]); o.w = pk_bf16(c2[2], c2[3]);
                    *(u32x4*)(hout + (size_t)(row0 + r) * 1024 + lane * 8 + 512 * h) = o; }
            }
        }
    }
#undef RCOL
#undef ROWS_LOAD_RAW
}

DI bf16x8 ld_u(const bf16_t* p) { return *(const bf16x8*)p; }
DI void ssm_item(const Params& p, LAS unsigned char* lds, int l, int item) {
    const int tid = otid(), wid = tid >> 6, lane = tid & 63, n = lane & 31, hh = lane >> 5;
    const int g = item >> 2, b = (item & 3) * 4 + (wid >> 1), dir = wid & 1;
    unsigned char* wl = p.ws + l * LAYER_W;
    const u32x4 ctab0 = *(const u32x4*)(wl + O_SC + (size_t)g * 8192 + tid * 16), ctab1 = *(const u32x4*)(wl + O_SC + (size_t)(24 + g) * 8192 + tid * 16);
    const f32x4 atab = *(const f32x4*)((const float*)(wl + O_SA) + (size_t)g * 128 + ((tid & 63) >> 5) * 24 * 128 + (tid & 31) * 4);
    __syncthreads();
    *(LAS u32x4*)(lds + tid * 16) = ctab0; *(LAS u32x4*)(lds + 8192 + tid * 16) = ctab1;
    if (tid < 64) *(LAS f32x4*)(lds + 16384 + tid * 16) = atab;
    __syncthreads();
    const LAS float* la = (const LAS float*)(lds + 16384) + dir * 128 + 4 * hh;
#define SSM_LDA(pt) f32x16 are_, aim_; _Pragma("unroll") for (int q_ = 0; q_ < 4; ++q_) { const f32x4 r4 = *(const LAS f32x4*)(la + (pt) * 32 + 8 * q_), i4 = *(const LAS f32x4*)(la + 64 + (pt) * 32 + 8 * q_); \
        _Pragma("unroll") for (int j_ = 0; j_ < 4; ++j_) { are_[4 * q_ + j_] = r4[j_]; aim_[4 * q_ + j_] = i4[j_]; } }
    bf16x8 bop[4];
#pragma unroll
    for (int t = 0; t < 4; ++t) bop[t] = *(const bf16x8*)((const bf16_t*)(wl + O_SB) + ((size_t)((dir * 24 + g) * 4 + t) * 64 + lane) * 8);
    const bf16_t* ut = (const bf16_t*)(p.ws + O_UT) + (size_t)(b * 24 + g) * (64 * 32 * 16);
    const long tstride = dir ? -512 : 512;
    const bf16_t* ubase = ut + (dir ? (63 * 32 + (31 - n)) * 16 : n * 16) + 8 * hh;
    f32x16 hre[2], him[2];
#pragma unroll
    for (int pt = 0; pt < 2; ++pt)
#pragma unroll
        for (int i = 0; i < 16; ++i) { hre[pt][i] = 0.f; him[pt][i] = 0.f; }
    {
        const int widu = __builtin_amdgcn_readfirstlane(wid);
        LAS unsigned char* ust = lds + 20480 + widu * 16384;
#pragma unroll
        for (int q = 0; q < 8; ++q) __builtin_amdgcn_global_load_lds((const unsigned*)(ubase + q * tstride), (LAS unsigned*)(ust + q * 1024), 16, 0, 0);
        for (int i0 = 0; i0 < 64; i0 += 8) {
            const int cur = (i0 >> 3) & 1;
            asm volatile("s_waitcnt vmcnt(0)" ::: "memory");
            if (i0 + 8 < 64) {
#pragma unroll
                for (int q = 0; q < 8; ++q) __builtin_amdgcn_global_load_lds((const unsigned*)(ubase + (i0 + 8 + q) * tstride), (LAS unsigned*)(ust + (cur ^ 1) * 8192 + q * 1024), 16, 0, 0);
            }
#pragma unroll
            for (int q = 0; q < 8; ++q) {
                const bf16x8 uc = *(const LAS bf16x8*)(ust + cur * 8192 + q * 1024 + lane * 16);
#pragma unroll
                for (int pt = 0; pt < 2; ++pt) {
                    asm volatile("" ::: "memory");
                    SSM_LDA(pt)
                    const f32x16 tr = are_ * hre[pt] - aim_ * him[pt], ti = are_ * him[pt] + aim_ * hre[pt];
                    hre[pt] = MFMA32(bop[pt], uc, tr); him[pt] = MFMA32(bop[2 + pt], uc, ti);
                }
            }
        }
    }
#pragma unroll
    for (int pt = 0; pt < 2; ++pt) {
        SSM_LDA(pt)
        f32x16 pr = are_, pi = aim_;
#pragma unroll
        for (int s = 0; s < 6; ++s) { const f32x16 nr = pr * pr - pi * pi, ni = 2.0f * pr * pi; pr = nr; pi = ni; }
#pragma unroll
        for (int d = 1; d < 32; d <<= 1) {
            const bool take = n >= d; const int src = take ? lane - d : lane;
#pragma unroll
            for (int i = 0; i < 16; ++i) {
                const float sr = bperm(hre[pt][i], src), si = bperm(him[pt][i], src);
                if (take) { hre[pt][i] += pr[i] * sr - pi[i] * si; him[pt][i] += pr[i] * si + pi[i] * sr; }
            }
            const f32x16 nr = pr * pr - pi * pi, ni = 2.0f * pr * pi; pr = nr; pi = ni;
        }
#pragma unroll
        for (int i = 0; i < 16; ++i) { const int src1 = n ? lane - 1 : lane; const float sr = bperm(hre[pt][i], src1), si = bperm(him[pt][i], src1); hre[pt][i] = n ? sr : 0.f; him[pt][i] = n ? si : 0.f; }
        asm volatile("" ::: "memory");
    }
    {
        float* yt = (float*)(p.ws + O_YFB) + (size_t)dir * MTOK * 384 + (size_t)(b * 24 + g) * (64 * 32 * 16);
        float* ybase = yt + (dir ? (63 * 32 + (31 - n)) * 16 : n * 16) + 4 * hh;
        const int widu = __builtin_amdgcn_readfirstlane(wid);
        const bf16x8 cbop = *(const bf16x8*)((const bf16_t*)(wl + O_CB) + ((size_t)(dir * 24 + g) * 64 + lane) * 8);
        f32x16 yacc;
#pragma unroll
        for (int i = 0; i < 16; ++i) yacc[i] = 0.f;
        LAS unsigned char* ust = lds + 20480 + widu * 16384;
#pragma unroll
        for (int q = 0; q < 8; ++q) __builtin_amdgcn_global_load_lds((const unsigned*)(ubase + q * tstride), (LAS unsigned*)(ust + q * 1024), 16, 0, 0);
        for (int i0 = 0; i0 < 64; i0 += 8) {
            const int cur = (i0 >> 3) & 1;
            asm volatile("s_waitcnt vmcnt(0)" ::: "memory");
            if (i0 + 8 < 64) {
#pragma unroll
                for (int q = 0; q < 8; ++q) __builtin_amdgcn_global_load_lds((const unsigned*)(ubase + (i0 + 8 + q) * tstride), (LAS unsigned*)(ust + (cur ^ 1) * 8192 + q * 1024), 16, 0, 0);
            }
#pragma unroll
            for (int q = 0; q < 8; ++q) {
                const bf16x8 uc = *(const LAS bf16x8*)(ust + cur * 8192 + q * 1024 + lane * 16);
#pragma unroll
                for (int pt = 0; pt < 2; ++pt) {
                    asm volatile("" ::: "memory");
                    SSM_LDA(pt)
                    const f32x16 tr = are_ * hre[pt] - aim_ * him[pt], ti = are_ * him[pt] + aim_ * hre[pt];
                    hre[pt] = MFMA32(bop[pt], uc, tr); him[pt] = MFMA32(bop[2 + pt], uc, ti);
                }
                if ((q & 1) == 0) {
                    f32x16 yac2;
#pragma unroll
                    for (int i = 0; i < 16; ++i) { yacc[i] = 0.f; yac2[i] = 0.f; }
#pragma unroll
                    for (int T = 0; T < 2; ++T) {
#pragma unroll
                        for (int s = 0; s < 2; ++s) {
                            const f32x16 hv = hre[T], hw = him[T];
                            const bf16x8 hb = pack8(hv[8 * s], hv[8 * s + 1], hv[8 * s + 2], hv[8 * s + 3], hv[8 * s + 4], hv[8 * s + 5], hv[8 * s + 6], hv[8 * s + 7]);
                            const bf16x8 hc = pack8(hw[8 * s], hw[8 * s + 1], hw[8 * s + 2], hw[8 * s + 3], hw[8 * s + 4], hw[8 * s + 5], hw[8 * s + 6], hw[8 * s + 7]);
                            const bf16x8 cop = *(const LAS bf16x8*)(lds + dir * 8192 + ((T * 2 + s) * 64 + lane) * 16);
                            const bf16x8 coq = *(const LAS bf16x8*)(lds + dir * 8192 + (((2 + T) * 2 + s) * 64 + lane) * 16);
                            yacc = MFMA32(cop, hb, yacc);
                            yac2 = MFMA32(coq, hc, yac2);
                        }
                    }
                    yacc += yac2;
                    float* yp = ybase + (i0 + q) * tstride;
                    *(f32x4*)yp = (f32x4){yacc[0], yacc[1], yacc[2], yacc[3]};
                    *(f32x4*)(yp + 8) = (f32x4){yacc[4], yacc[5], yacc[6], yacc[7]};
                } else {
                    yacc = MFMA32(cbop, uc, yacc);
                    float* yp = ybase + (i0 + q) * tstride;
                    *(f32x4*)yp = (f32x4){yacc[8], yacc[9], yacc[10], yacc[11]};
                    *(f32x4*)(yp + 8) = (f32x4){yacc[12], yacc[13], yacc[14], yacc[15]};
                }
            }
        }
    }
    __syncthreads();
    {
        const float* yf = (const float*)(p.ws + O_YFB) + (size_t)(b * 24 + g) * (64 * 32 * 16); const float* yb = yf + (size_t)MTOK * 384;
        bf16_t* ypre = (bf16_t*)(p.ws + O_YPRE);
        const float* dsk = p.in[I_DSKIP] + l * 384 + g * 16;
        const int t2 = tid & 127;
        const f32x4 d4 = *(const f32x4*)(dsk + (t2 & 3) * 4);
        for (int it = 0; it < 64; it += 8) {
            f32x4 a[8], bb[8]; u32x2 uw[8];
#pragma unroll
            for (int q = 0; q < 8; ++q) { const int idx = t2 + 128 * (it + q), c4 = (idx & 3) * 4, nn = (idx >> 2) & 31, ii = idx >> 7, e = (ii * 32 + nn) * 16 + c4;
                a[q] = *(const f32x4*)(yf + e); bb[q] = *(const f32x4*)(yb + e); uw[q] = *(const u32x2*)(ut + e); }
#pragma unroll
            for (int q = 0; q < 8; ++q) { const int idx = t2 + 128 * (it + q), c4 = (idx & 3) * 4, nn = (idx >> 2) & 31, ii = idx >> 7;
                const size_t tok = (size_t)b * 2048 + 64 * nn + ii;
                const float y0 = a[q][0] + bb[q][0] + d4[0] * bf_lo(uw[q].x), y1 = a[q][1] + bb[q][1] + d4[1] * bf_hi(uw[q].x), y2 = a[q][2] + bb[q][2] + d4[2] * bf_lo(uw[q].y), y3 = a[q][3] + bb[q][3] + d4[3] * bf_hi(uw[q].y);
                u32x2 w; w.x = pk_bf16(gelu_tanh(y0), gelu_tanh(y1)); w.y = pk_bf16(gelu_tanh(y2), gelu_tanh(y3));
                *(u32x2*)(ypre + tok * 384 + g * 16 + c4) = w; }
        }
    }
}

DI void attn_item(const Params& p, LAS unsigned char* lds, int l, int item) {
    const int tid = otid(), wid = tid >> 6, lane = tid & 63, n = lane & 31, hh = lane >> 5;
    const int b = item >> 5, blk = (item >> 1) & 15, kvh = item & 1;
    const bf16_t* z = (const bf16_t*)(p.ws + O_Z);
    bf16_t* ycat = (bf16_t*)(p.ws + O_YCAT);
    constexpr int KROW = 144, VROW = 784, VOFF = 384 * KROW;
    __syncthreads();
    for (int c = tid; c < 3072; c += NTHREADS) {
        const int j = c >> 3, dc = c & 7, pos = blk * 128 - 128 + j;
        u32x4 kv = {0u, 0u, 0u, 0u};
        if (pos >= 0 && pos < 2048) kv = *(const u32x4*)(z + ((size_t)b * 2048 + pos) * 1024 + 768 + kvh * 64 + dc * 8);
        *(LAS u32x4*)(lds + j * KROW + dc * 16) = kv;
    }
    for (int c = tid; c < 3072; c += NTHREADS) {
        const int j = c % 384, dc = c / 384, pos = blk * 128 - 128 + j;
        u32x4 vv = {0u, 0u, 0u, 0u};
        if (pos >= 0 && pos < 2048) vv = *(const u32x4*)(z + ((size_t)b * 2048 + pos) * 1024 + 896 + kvh * 64 + dc * 8);
        LAS bf16_t* vt = (LAS bf16_t*)(lds + VOFF + (dc * 8) * VROW) + j;
        vt[0 * (VROW / 2)] = (bf16_t)(vv.x & 0xffff); vt[1 * (VROW / 2)] = (bf16_t)(vv.x >> 16);
        vt[2 * (VROW / 2)] = (bf16_t)(vv.y & 0xffff); vt[3 * (VROW / 2)] = (bf16_t)(vv.y >> 16);
        vt[4 * (VROW / 2)] = (bf16_t)(vv.z & 0xffff); vt[5 * (VROW / 2)] = (bf16_t)(vv.z >> 16);
        vt[6 * (VROW / 2)] = (bf16_t)(vv.w & 0xffff); vt[7 * (VROW / 2)] = (bf16_t)(vv.w >> 16);
    }
    __syncthreads();
    for (int task = wid; task < 12; task += 8) {
        const int head = kvh * 3 + (task >> 2), qt = task & 3;
        const float slope2 = exp2f(-8.0f * (float)(head + 1) / 6.0f) * 1.442695041f;
        const float sink2 = p.in[I_SINK][l * 6 + head] * 1.442695041f;
        const int qi = 32 * qt + n;
        const size_t tok = (size_t)b * 2048 + blk * 128 + qi;
        bf16x8 qop[4];
#pragma unroll
        for (int s = 0; s < 4; ++s) qop[s] = *(const bf16x8*)(z + tok * 1024 + 384 + head * 64 + 16 * s + 8 * hh);
        f32x16 o0, o1;
#pragma unroll
        for (int i = 0; i < 16; ++i) { o0[i] = 0.f; o1[i] = 0.f; }
        float mrun = sink2, lrun = 0.f;
        float dbase[16];
#pragma unroll
        for (int r = 0; r < 16; ++r) dbase[r] = (float)(128 + n - ((r & 3) + 8 * (r >> 2) + 4 * hh));
        const bool edge_blk = (blk == 0) || (blk == 15);
        for (int kt = qt; kt < qt + 9; ++kt) {
            f32x16 sacc;
#pragma unroll
            for (int i = 0; i < 16; ++i) sacc[i] = 0.f;
#pragma unroll
            for (int s = 0; s < 4; ++s) { const bf16x8 kop = *(const LAS bf16x8*)(lds + (kt * 32 + n) * KROW + (16 * s + 8 * hh) * 2); sacc = MFMA32(kop, qop[s], sacc); }
            const int dk = kt - qt;
            const float off = 32.0f * (float)dk;
            float mx = -1e30f;
            if (dk == 0 || dk == 8 || edge_blk) {
#pragma unroll
                for (int r = 0; r < 16; ++r) {
                    const int j = kt * 32 + (r & 3) + 8 * (r >> 2) + 4 * hh, pos = blk * 128 - 128 + j;
                    const float d = dbase[r] - off;
                    const bool valid = fabsf(d) <= 128.0f && pos >= 0 && pos < 2048;
                    const float sc = valid ? sacc[r] * 0.1803368801f - slope2 * fabsf(d) : -1e30f;
                    sacc[r] = sc; mx = fmaxf(mx, sc);
                }
            } else {
#pragma unroll
                for (int r = 0; r < 16; ++r) { const float sc = sacc[r] * 0.1803368801f - slope2 * fabsf(dbase[r] - off); sacc[r] = sc; mx = fmaxf(mx, sc); }
            }
            mx = fmaxf(mx, bperm(mx, lane ^ 32));
            const float mnew = fmaxf(mrun, mx);
            if (__builtin_amdgcn_ballot_w64(mnew != mrun) != 0ull) {
                const float alpha = __builtin_amdgcn_exp2f(mrun - mnew);
                lrun *= alpha; o0 *= alpha; o1 *= alpha; mrun = mnew;
            }
            float ls = 0.f;
#pragma unroll
            for (int r = 0; r < 16; ++r) { const float pv = __builtin_amdgcn_exp2f(sacc[r] - mrun); sacc[r] = pv; ls += pv; }
            lrun += ls;
#pragma unroll
            for (int s = 0; s < 2; ++s) {
                const bf16x8 pb = pack8(sacc[8 * s], sacc[8 * s + 1], sacc[8 * s + 2], sacc[8 * s + 3], sacc[8 * s + 4], sacc[8 * s + 5], sacc[8 * s + 6], sacc[8 * s + 7]);
#pragma unroll
                for (int dt = 0; dt < 2; ++dt) {
                    const LAS unsigned char* vp = lds + VOFF + (dt * 32 + n) * VROW + (kt * 32 + 16 * s + 4 * hh) * 2;
                    const s16x4 lo = *(const LAS s16x4*)vp, hi = *(const LAS s16x4*)(vp + 16);
                    const bf16x8 vop = __builtin_shufflevector(lo, hi, 0, 1, 2, 3, 4, 5, 6, 7);
                    if (dt == 0) o0 = MFMA32(vop, pb, o0); else o1 = MFMA32(vop, pb, o1);
                }
            }
        }
        const float ltot = lrun + bperm(lrun, lane ^ 32);
        const float inv = 1.0f / (ltot + __builtin_amdgcn_exp2f(sink2 - mrun));
        bf16_t* op = ycat + tok * 1024 + 640 + head * 64 + 4 * hh;
#pragma unroll
        for (int q = 0; q < 4; ++q) {
            u32x2 w0; w0.x = pk_bf16(o0[4 * q] * inv, o0[4 * q + 1] * inv); w0.y = pk_bf16(o0[4 * q + 2] * inv, o0[4 * q + 3] * inv);
            u32x2 w1; w1.x = pk_bf16(o1[4 * q] * inv, o1[4 * q + 1] * inv); w1.y = pk_bf16(o1[4 * q + 2] * inv, o1[4 * q + 3] * inv);
            *(u32x2*)(op + 8 * q) = w0; *(u32x2*)(op + 32 + 8 * q) = w1;
        }
    }
}

#define XB_TMO      128
#define XB_XCNT(j)  (256  + 64 * (j))
#define XB_XSUB(j)  (1280 + 64 * (j))
#define XB_XGEN(j)  (2304 + 64 * (j))
#define XB_TOP      3328
#define XB_TOPGEN   3392
#define XB_SPIN_CAP (1u << 20)
DI unsigned xb_ld(unsigned* p) { return __hip_atomic_load(p, __ATOMIC_RELAXED, __HIP_MEMORY_SCOPE_AGENT); }
DI unsigned xb_add(unsigned* p, unsigned v) { return __hip_atomic_fetch_add(p, v, __ATOMIC_RELAXED, __HIP_MEMORY_SCOPE_AGENT); }
DI unsigned xb_xcc_id() { return (unsigned)__builtin_amdgcn_s_getreg((3 << 11) | 20) & 0xFu; }
#define XB_SPIN(cond, bar) do { unsigned _sp = 0; while (cond) { __builtin_amdgcn_s_sleep(1); \
    if ((++_sp & 255u) == 0u) { if (xb_ld(&(bar)[XB_TMO])) break; if (_sp > XB_SPIN_CAP) { atomicAdd(&(bar)[XB_TMO], 1u); break; } } } } while (0)
DI void xcd_barrier_complete(unsigned* bar, unsigned x, unsigned& nloc, unsigned& nx) {
    const unsigned G = gridDim.x;
    unsigned sum, cnt, mine, sp = 0u;
    for (;;) {
        sum = 0u; cnt = 0u; mine = 0u;
#pragma unroll
        for (unsigned j = 0; j < 16; ++j) { const unsigned c = xb_ld(&bar[XB_XCNT(j)]); sum += c; cnt += (c > 0u) ? 1u : 0u; mine = (j == x) ? c : mine; }
        if (sum == G) break;
        __builtin_amdgcn_s_sleep(1);
        if ((++sp & 255u) == 0u) { if (xb_ld(&bar[XB_TMO])) break; if (sp > XB_SPIN_CAP) { atomicAdd(&bar[XB_TMO], 1u); break; } }
    }
    nloc = mine > 0u ? mine : 1u; nx = cnt > 0u ? cnt : 1u;
}
DI void xcd_barrier(unsigned* bar, volatile LAS unsigned* st) {
    asm volatile("s_waitcnt vmcnt(0)" ::: "memory");
    __syncthreads();
    if (otid() == 0) {
        __builtin_amdgcn_s_waitcnt(0);
        const unsigned x = xb_xcc_id();
        unsigned nloc = st[0], nx = st[1];
        if (nloc == 0u) { xcd_barrier_complete(bar, x, nloc, nx); st[0] = nloc; st[1] = nx; }
        const unsigned old = xb_add(&bar[XB_XSUB(x)], 1u);
        const unsigned gen = old / nloc;
        if (old + 1u == (gen + 1u) * nloc) {
            __builtin_amdgcn_fence(__ATOMIC_RELEASE, "agent");
            asm volatile("s_waitcnt vmcnt(0)" ::: "memory");
            const unsigned og = xb_add(&bar[XB_TOP], 1u);
            const unsigned tg = og / nx;
            if (og + 1u == (tg + 1u) * nx) xb_add(&bar[XB_TOPGEN], 1u);
            else XB_SPIN(xb_ld(&bar[XB_TOPGEN]) == tg, bar);
            __builtin_amdgcn_fence(__ATOMIC_ACQUIRE, "agent");
            xb_add(&bar[XB_XGEN(x)], 1u);
            asm volatile("s_waitcnt vmcnt(0)" ::: "memory");
        } else {
            XB_SPIN(xb_ld(&bar[XB_XGEN(x)]) == gen, bar);
            __builtin_amdgcn_fence(__ATOMIC_ACQUIRE, "agent");
            asm volatile("s_waitcnt vmcnt(0)" ::: "memory");
        }
    }
    __syncthreads();
}
#define EN(k) (((PHASE_EN) >> (k)) & 1u)
constexpr int NPHASE = 2 + 9 * NL;
template <unsigned PHASE_EN> __global__ void __launch_bounds__(NTHREADS, 2) fwd_megakernel(Params p_arg) {
    extern __shared__ __attribute__((aligned(16))) unsigned char lds_raw[];
    LAS unsigned char* lds = (LAS unsigned char*)lds_raw;
    cg::grid_group grid = cg::this_grid();
    const int ph_lo = p_arg.ph_lo, ph_hi = p_arg.ph_hi;
    volatile LAS unsigned* xst = (volatile LAS unsigned*)(lds + LDS_BYTES - 32);
    if (threadIdx.x == 0) { xst[0] = 0u; xst[1] = 0u; (void)xb_add((unsigned*)(p_arg.ws + O_CTR + 1024) + XB_XCNT(xb_xcc_id()), 1u); }
    __syncthreads();
    for (int ph = ph_lo; ph < ph_hi; ++ph) {
#if defined(__HIP_DEVICE_COMPILE__)
        const __attribute__((address_space(4))) Params* pp = (const __attribute__((address_space(4))) Params*)__builtin_amdgcn_kernarg_segment_ptr();
        asm volatile("" : "+s"(pp));
        const Params p = *pp;
#else
        const Params p = p_arg;
#endif
        unsigned char* ws = p.ws;
        const float* mod = (const float*)(ws + O_MOD);
        if (ph == 0) { if (EN(0)) phase_prep(p, lds); }
        else if (ph == 1) {
            if (EN(1)) phase_rows<false>(p.in[I_X], nullptr, nullptr, nullptr, nullptr, nullptr, nullptr, 0, nullptr, false, true, mod, 0, 1024, p.in[I_GPREMIX], (bf16_t*)(ws + O_H));
        } else {
            const int l = (ph - 2) / 9, sp = (ph - 2) % 9;
            unsigned char* wl = ws + l * LAYER_W;
            const float* modl = mod + (size_t)l * 16 * 6144;
            if (sp == 0) {
                SchedInproj S; S.bid = obid(); S.h = (const char*)(ws + O_H); S.win = (const char*)(wl + O_WIN); S.wpq = (const char*)(wl + O_WPQ); S.z = (char*)(ws + O_Z); S.pqt = (char*)(ws + O_PQT);
                S.m1.init(128, 4); S.m2.init(2, 128);
                EpiInproj E; E.ut = (bf16_t*)(ws + O_UT); if (EN(2)) gemm_phase(lds, 1024, 1024, 1024, 1 << 30, 0, S, E);
            } else if (sp == 1) {
                unsigned* ctr = (unsigned*)(ws + O_CTR) + l;
                LAS int* sitem = (LAS int*)(lds + LDS_BYTES - 16);
                for (;;) {
                    __syncthreads();
                    if (otid() == 0) *sitem = (int)atomicAdd(ctr, 1u);
                    __syncthreads();
                    const int qitem = *sitem;
                    if (qitem >= 128 + 96 + 512) break;
                    const int item = qitem < 96 ? qitem + 128 : (qitem < 224 ? qitem - 96 : qitem);
                    if (item < 128) {
                        const int bb = item >> 3, which = (item >> 2) & 1, jt = item & 3;
                        SchedOne S; S.u0.A = (const char*)(ws + O_DFT) + (size_t)(which * 1024 + jt * 256) * 2048 * 2; S.u0.B = (const char*)(ws + O_PQT) + ((size_t)which * 256 * MTOK + (size_t)bb * 2048) * 2;
                        S.u0.C = (char*)(ws + O_AB) + ((size_t)((which * 16 + bb) * 1024 + jt * 256) * 256) * 4; S.u0.ldc = 256; S.u0.pm = jt; S.u0.pn = bb; S.u0.kind = 1;
                        EpiF32 E; if (EN(3)) gemm_phase(lds, 2048, 2048, MTOK, 1 << 30, 0, S, E);
                    } else if (item < 224) { if (EN(4)) ssm_item(p, lds, l, item - 128); }
                    else { if (EN(5)) attn_item(p, lds, l, item - 224); }
                }
            } else if (sp == 2) {
                {
                    const float* ab = (const float*)(ws + O_AB); bf16_t* yc = (bf16_t*)(ws + O_YCAT);
                    const int gt_ = obid() * NTHREADS + otid();
                    const int gstride = (int)gridDim.x * NTHREADS;
                    for (int idx0 = gt_; idx0 < 16 * 1024 * 64; idx0 += 8 * gstride) {
                        f32x4 av[8], bv[8];
#pragma unroll
                        for (int q = 0; q < 8; ++q) { const int idx = idx0 + q * gstride; const bool ok = idx < 16 * 1024 * 64;
                            const int n4 = (idx & 63) * 4, jj = (idx >> 6) & 1023, bb = ok ? idx >> 16 : 0;
                            av[q] = *(const f32x4*)(ab + ((size_t)(bb * 1024 + jj) * 256 + n4)); bv[q] = *(const f32x4*)(ab + ((size_t)((16 + bb) * 1024 + jj) * 256 + n4)); }
#pragma unroll
                        for (int q = 0; q < 8; ++q) { const int idx = idx0 + q * gstride;
                            if (idx < 16 * 1024 * 64) {
                                const int n4 = (idx & 63) * 4, jj = (idx >> 6) & 1023, bb = idx >> 16, j = jj + 1;
                                const f32x4 a = av[q], b4 = bv[q];
                                u32x2 lo, hi; lo.x = pk_bf16(a[0] - b4[0], a[1] - b4[1]); lo.y = pk_bf16(a[2] - b4[2], a[3] - b4[3]);
                                hi.x = pk_bf16(a[0] + b4[0], a[1] + b4[1]); hi.y = pk_bf16(a[2] + b4[2], a[3] + b4[3]);
                                *(u32x2*)(yc + ((size_t)(bb * 2048 + j) * 1024 + 384 + n4)) = lo;
                                *(u32x2*)(yc + ((size_t)(bb * 2048 + 2048 - j) * 1024 + 384 + n4)) = hi; } }
                    }
                    const bf16_t* pq = (const bf16_t*)(ws + O_PQT);
                    const int lane_ = otid() & 63;
                    for (int w = gt_ >> 6; w < 16 * 256; w += (int)gridDim.x * 8) {
                        const int bb = w >> 8, n = w & 255;
                        const bf16_t* src = pq + (size_t)n * MTOK + (size_t)bb * 2048 + lane_ * 32;
                        float sum = 0.f;
#pragma unroll
                        for (int q = 0; q < 4; ++q) { const u32x4 v = *(const u32x4*)(src + q * 8);
                            sum += (bf_lo(v.x) + bf_hi(v.x)) + (bf_lo(v.y) + bf_hi(v.y)) + (bf_lo(v.z) + bf_hi(v.z)) + (bf_lo(v.w) + bf_hi(v.w)); }
                        sum = wave_sum(sum, lane_);
                        if (lane_ == 0) yc[(size_t)(bb * 2048) * 1024 + 384 + n] = f2bf(sum * 0.02209708691f);
                    }
                }
                SchedPlain S; S.bid = obid(); S.A = (const char*)(ws + O_YPRE); S.B = (const char*)(wl + O_WGLU); S.K = 384; S.total = 256; S.tm.init(128, 2);
                EpiGlu E; E.ypre = (const bf16_t*)(ws + O_YPRE); E.ycat = (bf16_t*)(ws + O_YCAT);
                if (EN(6)) gemm_phase(lds, 384, 384, 384, 1 << 30, 0, S, E);
            } else if (sp == 3) {
                SchedPlain S; S.bid = obid(); S.A = (const char*)(ws + O_YCAT); S.B = (const char*)(wl + O_WOUT); S.K = 1024; S.total = 512; S.tm.init(128, 4);
                EpiY E; E.y = (bf16_t*)(ws + O_Y); E.rss = (float*)(ws + O_RSS);
                if (EN(7)) gemm_phase(lds, 1024, 1024, 1024, 1 << 30, 0, S, E);
            } else if (sp == 4) {
                if (l == 0) phase_rows<false>(p.in[I_X], nullptr, nullptr, (bf16_t*)(ws + O_XB), (const bf16_t*)(ws + O_Y), (const float*)(ws + O_RSS), modl, 2048, p.in[I_GPOSTMIX] + l * 1024, true,
                           true, modl, 3072, 4096, p.in[I_GPREFFN] + l * 1024, (bf16_t*)(ws + O_H));
                else phase_rows<true>(nullptr, (const bf16_t*)(ws + O_XB), nullptr, (bf16_t*)(ws + O_XB), (const bf16_t*)(ws + O_Y), (const float*)(ws + O_RSS), modl, 2048, p.in[I_GPOSTMIX] + l * 1024, true,
                           true, modl, 3072, 4096, p.in[I_GPREFFN] + l * 1024, (bf16_t*)(ws + O_H));
            } else if (sp == 5) {
                SchedPlain S; S.bid = obid(); S.A = (const char*)(ws + O_H); S.B = (const char*)(wl + O_WUP); S.K = 1024; S.total = 128 * 22; S.tm.init(128, 22);
                EpiUp E; E.act = (bf16_t*)(ws + O_ACT); E.edge = (bf16_t*)(ws + O_EDGE); E.cw = p.in[I_CONVW] + (size_t)l * 3 * 5632; E.cb = p.in[I_CONVB] + (size_t)l * 5632;
                if (EN(8)) gemm_phase(lds, 1024, 1024, 1024, 1 << 30, 0, S, E);
            } else if (sp == 6) { if (EN(9)) {
                const bf16_t* edge = (const bf16_t*)(ws + O_EDGE); bf16_t* act = (bf16_t*)(ws + O_ACT);
                const float* cw = p.in[I_CONVW] + (size_t)l * 3 * 5632; const float* cb = p.in[I_CONVB] + (size_t)l * 5632;
                for (int idx = obid() * NTHREADS + otid(); idx < 512 * 2 * 704; idx += gridDim.x * NTHREADS) {
                    const int c4 = (idx % 704) * 4, which = (idx / 704) & 1, seg = idx / 1408;
                    const int t = seg * 64 + (which ? 63 : 0);
                    const bf16_t* ec = edge + (size_t)(seg * 4 + (which ? 3 : 0)) * 2 * DFF;
                    const bf16_t* ep = which ? edge + (size_t)(seg * 4 + 2) * 2 * DFF : ((seg & 31) == 0 ? nullptr : edge + (size_t)((seg - 1) * 4 + 3) * 2 * DFF);
                    const bf16_t* en = which ? ((seg & 31) == 31 ? nullptr : edge + (size_t)((seg + 1) * 4 + 0) * 2 * DFF) : edge + (size_t)(seg * 4 + 1) * 2 * DFF;
                    const u32x2 z2 = {0u, 0u};
                    const u32x2 gpw = ep ? *(const u32x2*)(ep + c4) : z2, gcw = *(const u32x2*)(ec + c4), gnw = en ? *(const u32x2*)(en + c4) : z2;
                    const u32x2 vpw = ep ? *(const u32x2*)(ep + DFF + c4) : z2, vcw = *(const u32x2*)(ec + DFF + c4), vnw = en ? *(const u32x2*)(en + DFF + c4) : z2;
                    const f32x4 wg0 = *(const f32x4*)(cw + c4), wg1 = *(const f32x4*)(cw + 5632 + c4), wg2 = *(const f32x4*)(cw + 2 * 5632 + c4), bg = *(const f32x4*)(cb + c4);
                    const f32x4 wv0 = *(const f32x4*)(cw + 2816 + c4), wv1 = *(const f32x4*)(cw + 5632 + 2816 + c4), wv2 = *(const f32x4*)(cw + 2 * 5632 + 2816 + c4), bv = *(const f32x4*)(cb + 2816 + c4);
                    const f32x4 gp = {bf_lo(gpw.x), bf_hi(gpw.x), bf_lo(gpw.y), bf_hi(gpw.y)}, gc = {bf_lo(gcw.x), bf_hi(gcw.x), bf_lo(gcw.y), bf_hi(gcw.y)}, gn = {bf_lo(gnw.x), bf_hi(gnw.x), bf_lo(gnw.y), bf_hi(gnw.y)};
                    const f32x4 vp = {bf_lo(vpw.x), bf_hi(vpw.x), bf_lo(vpw.y), bf_hi(vpw.y)}, vc = {bf_lo(vcw.x), bf_hi(vcw.x), bf_lo(vcw.y), bf_hi(vcw.y)}, vn = {bf_lo(vnw.x), bf_hi(vnw.x), bf_lo(vnw.y), bf_hi(vnw.y)};
                    const f32x4 ug = wg0 * gp + wg1 * gc + wg2 * gn + bg, uv = wv0 * vp + wv1 * vc + wv2 * vn + bv;
                    float o[4];
#pragma unroll
                    for (int j = 0; j < 4; ++j) o[j] = gelu_tanh(ug[j]) * uv[j];
                    u32x2 w; w.x = pk_bf16(o[0], o[1]); w.y = pk_bf16(o[2], o[3]);
                    *(u32x2*)(act + (size_t)t * DFF + c4) = w;
                } }
            } else if (sp == 7) {
                SchedPlain S; S.bid = obid(); S.A = (const char*)(ws + O_ACT); S.B = (const char*)(wl + O_WDN); S.K = 2816; S.total = 512; S.tm.init(128, 4);
                EpiY E; E.y = (bf16_t*)(ws + O_Y); E.rss = (float*)(ws + O_RSS);
                if (EN(10)) gemm_phase(lds, 2816, 2816, 2816, 1 << 30, 0, S, E);
            } else {
                const bool has_next = (l + 1 < NL);
                const float* modn = mod + (size_t)(l + 1) * 16 * 6144;
                phase_rows<true>(nullptr, (const bf16_t*)(ws + O_XB), p.out, has_next ? (bf16_t*)(ws + O_XB) : nullptr, (const bf16_t*)(ws + O_Y), (const float*)(ws + O_RSS), modl, 5120, p.in[I_GPOSTFFN] + l * 1024, true,
                           has_next, modn, 0, 1024, p.in[I_GPREMIX] + (has_next ? (l + 1) * 1024 : 0), (bf16_t*)(ws + O_H));
            }
        }
        if (ph + 1 < ph_hi) { if (ph_hi < 0) grid.sync();   xcd_barrier((unsigned*)(ws + O_CTR + 1024), xst); }
    }
}

constexpr unsigned ALL_KINDS = 0x7ffu;
extern "C" void kernel_launch(void* const* d_in, const int* in_sizes, int n_in, void* d_out, int out_size, void* d_ws, size_t ws_size, hipStream_t stream) {
    static int grid_blocks = 0;
    if (!grid_blocks) {
        int dev = 0, cus = 0, per_cu = 0;
        (void)hipGetDevice(&dev);
        (void)hipDeviceGetAttribute(&cus, hipDeviceAttributeMultiprocessorCount, dev);
        (void)hipFuncSetAttribute((const void*)fwd_megakernel<ALL_KINDS>, hipFuncAttributeMaxDynamicSharedMemorySize, LDS_BYTES);
        (void)hipOccupancyMaxActiveBlocksPerMultiprocessor(&per_cu, fwd_megakernel<ALL_KINDS>, NTHREADS, LDS_BYTES);
        if (per_cu < 1) per_cu = 1;
        grid_blocks = cus * per_cu;
        if (grid_blocks > 256) grid_blocks = 256;
        if (grid_blocks < 8) grid_blocks = 8;
    }
    Params p{};
    for (int i = 0; i < 25; ++i) p.in[i] = (const float*)d_in[i];
    p.out = (float*)d_out; p.ws = (unsigned char*)d_ws; p.ph_lo = 0; p.ph_hi = NPHASE;
    (void)hipMemsetAsync((unsigned char*)d_ws + O_CTR, 0, 16384, stream);
    void* args[] = {&p};
    hipError_t e = hipLaunchCooperativeKernel((const void*)fwd_megakernel<ALL_KINDS>, dim3(grid_blocks), dim3(NTHREADS), args, LDS_BYTES, stream);
    if (e != hipSuccess) fprintf(stderr, "cooperative launch failed: %s (grid %d)\n", hipGetErrorString(e), grid_blocks);
}
```

```cpp
#include <hip/hip_runtime.h>
#include <hip/hip_cooperative_groups.h>
#include <cstdio>
namespace cg = cooperative_groups;

#define DI __device__ __forceinline__
#define LAS __attribute__((address_space(3)))
typedef unsigned short bf16_t;
typedef short bf16x8 __attribute__((ext_vector_type(8)));
typedef short s16x4 __attribute__((ext_vector_type(4)));
typedef float f32x2 __attribute__((ext_vector_type(2)));
typedef float f32x4 __attribute__((ext_vector_type(4)));
typedef float f32x16 __attribute__((ext_vector_type(16)));
typedef unsigned u32x2 __attribute__((ext_vector_type(2)));
typedef unsigned u32x4 __attribute__((ext_vector_type(4)));
typedef __bf16 nbf16x2 __attribute__((ext_vector_type(2)));

constexpr int MTOK = 32768, DM = 1024, SEQ = 2048, NB = 16, NL = 2, DFF = 2816;
constexpr int BM = 256, BK = 64, HALF = 128, HTB = HALF * BK * 2, STAGE_BYTES = 8 * HTB;
constexpr int LDS_BYTES = 155648;
constexpr int NTHREADS = 512;

constexpr size_t O_WIN = 0;
constexpr size_t O_WPQ = O_WIN + 1024ull * 1024 * 2;
constexpr size_t O_WGLU = O_WPQ + 512ull * 1024 * 2;
constexpr size_t O_WOUT = O_WGLU + 512ull * 384 * 2;
constexpr size_t O_WUP = O_WOUT + 1024ull * 1024 * 2;
constexpr size_t O_WDN = O_WUP + 5632ull * 1024 * 2;
constexpr size_t O_SA = O_WDN + 1024ull * 2816 * 2;
constexpr size_t O_SB = O_SA + 2ull * 24 * 2 * 64 * 4;
constexpr size_t O_SC = O_SB + 2ull * 24 * 4 * 64 * 8 * 2;
constexpr size_t O_CB = O_SC + 2ull * 24 * 8 * 64 * 8 * 2;
constexpr size_t LAYER_W = O_CB + 2ull * 24 * 64 * 8 * 2;
constexpr size_t O_DFT = 2 * LAYER_W;
constexpr size_t O_MOD = O_DFT + 2048ull * 4096 * 2;
constexpr size_t O_CTR = O_MOD + 2ull * 16 * 6144 * 4;
constexpr size_t O_H = O_CTR + 16384;
constexpr size_t O_Y = O_H + (size_t)MTOK * 1024 * 2;
constexpr size_t O_RSS = O_Y + (size_t)MTOK * 1024 * 2;
constexpr size_t O_Z = O_RSS + (size_t)MTOK * 16 * 4;
constexpr size_t O_PQT = O_Z + (size_t)MTOK * 1024 * 2;
constexpr size_t O_YPRE = O_PQT + 512ull * MTOK * 2;
constexpr size_t O_YCAT = O_YPRE + (size_t)MTOK * 384 * 2;
constexpr size_t O_EDGE = O_YCAT + (size_t)MTOK * 1024 * 2;
constexpr size_t O_UT = O_EDGE + 512ull * 4 * 5632 * 2;
constexpr size_t O_XB = O_UT + (size_t)MTOK * 384 * 2;
constexpr size_t O_END = O_XB + (size_t)MTOK * 1024 * 2;
constexpr size_t O_AB = O_H + 2ull * MTOK * 384 * 4;
static_assert(O_AB + 2ull * 16 * 1024 * 256 * 4 <= O_H + 2ull * MTOK * 1024 * 2, "ab alias");
constexpr size_t O_YFB = O_H;
constexpr size_t O_ACT = O_Z;
static_assert(2ull * MTOK * 384 * 4 <= 2ull * MTOK * 1024 * 2, "yfb alias");
static_assert((size_t)MTOK * 2816 * 2 <= O_EDGE - O_Z, "act alias");

struct Params {
    const float* in[25];
    float* out;
    unsigned char* ws;
    int ph_lo, ph_hi;
};
enum { I_X = 0, I_C, I_WADA, I_BADA, I_GPREMIX, I_GPOSTMIX, I_GPREFFN, I_GPOSTFFN, I_WIN, I_LAMRE, I_LAMIM, I_LOGDT, I_BRE, I_BIM, I_CRE, I_CIM,
       I_DSKIP, I_WGLU, I_WFFT, I_SINK, I_WOUT, I_WUP, I_CONVW, I_CONVB, I_WDOWN };

DI unsigned pk_bf16(float lo, float hi) {
    f32x2 v = {lo, hi};
    nbf16x2 b = __builtin_convertvector(v, nbf16x2);
    return __builtin_bit_cast(unsigned, b);
}
DI float bf_lo(unsigned w) { return __uint_as_float(w << 16); }
DI float bf_hi(unsigned w) { return __uint_as_float(w & 0xffff0000u); }
DI float bf2f(bf16_t b) { return __uint_as_float(((unsigned)b) << 16); }
DI bf16_t f2bf(float f) { return (bf16_t)(pk_bf16(f, 0.f) & 0xffffu); }
DI float gelu_tanh(float x) {
    float t = x * (1.0f + 0.044715f * x * x);
    float e = __builtin_amdgcn_exp2f(-2.302208198f * t);
    return x * __builtin_amdgcn_rcpf(1.0f + e);
}
DI float sigmoidf_(float x) { return __builtin_amdgcn_rcpf(1.0f + __builtin_amdgcn_exp2f(-1.442695041f * x)); }
DI bf16x8 pack8(float a0, float a1, float a2, float a3, float a4, float a5, float a6, float a7) {
    u32x4 w; w.x = pk_bf16(a0, a1); w.y = pk_bf16(a2, a3); w.z = pk_bf16(a4, a5); w.w = pk_bf16(a6, a7);
    return __builtin_bit_cast(bf16x8, w);
}
DI int otid() { int t = threadIdx.x; asm volatile("" : "+v"(t)); return t; }
DI int obid() { int b = blockIdx.x; asm volatile("" : "+s"(b)); return b; }
DI float bperm(float v, int srclane) { return __int_as_float(__builtin_amdgcn_ds_bpermute(srclane << 2, __float_as_int(v))); }
#define MFMA32(a, b, c) __builtin_amdgcn_mfma_f32_32x32x16_bf16((a), (b), (c), 0, 0, 0)

DI int lds_byte(int r, int c) { const int st = (r >> 4) * 2 + (c >> 5), rr = r & 15, cc = c & 31, ob = rr * 64 + cc * 2; return st * 1024 + (ob ^ (((ob >> 9) & 1) << 5)); }
DI void stage_rc(int b, int& R, int& C) { const int st = b / 1024, sb = b % 1024, swz = sb ^ (((sb >> 9) & 1) << 5); R = (st >> 1) * 16 + swz / 64; C = (st & 1) * 32 + (swz % 64) / 2; }
DI int perm32(int rho) { const int n = rho >> 4, i = rho & 15; return 8 * (i >> 2) + 4 * n + (i & 3); }

struct Unit { const char* A; const char* B; char* C; int ldc; int pm, pn; int kind; };
struct TileMap {
    int nM, nN, nwg;
    DI void init(int nM_, int nN_) { nM = nM_; nN = nN_; nwg = nM_ * nN_; }
    DI void get(int L, int& pm, int& pn) const {
        int wgid = L; { const int q = nwg / 8, r = nwg % 8, xcd = wgid % 8, off = wgid / 8; wgid = (xcd < r ? xcd * (q + 1) : r * (q + 1) + (xcd - r) * q) + off; }
        const int nig = 8 * nN, gid = wgid / nig, fm = gid * 8, gsz = (nM - fm) < 8 ? (nM - fm) : 8;
        pm = fm + ((wgid % nig) % gsz); pn = (wgid % nig) / gsz;
    }
};

template <class Epi, class Sched>
DI void gemm_phase(LAS unsigned char* lds, const int K, const int lda, const int ldb, const int jt, const long jumpB, Sched& S, const Epi& E) {
    const int tid = otid(), wid = __builtin_amdgcn_readfirstlane(tid >> 6), lane = tid & 63, wr = wid >> 2, wc = wid & 3, fr = lane & 15, fq = lane >> 4;
    const int nt = K / BK;
    unsigned voffA[2], voffB[2];
#pragma unroll
    for (int i = 0; i < 2; ++i) { int R, C; stage_rc(tid * 16 + i * 8192, R, C); const int Rb = (R >> 5) * 64 + perm32(R & 31);
        const int Ra = Epi::APERM ? ((R & ~63) + 4 * (R & 15) + ((R >> 4) & 3)) : R;
        voffA[i] = (unsigned)(Ra * lda + C) * 2u; voffB[i] = (unsigned)(Rb * ldb + C) * 2u; }
    const size_t kstep = (size_t)(BK * 2);
    const size_t hstepA = (size_t)HALF * lda * 2, hstepB = (size_t)32 * ldb * 2;
    const unsigned ldsw = (unsigned)wid * 1024u;
    const int aoff = lds_byte(wr * 64 + fr, fq * 8), boff = lds_byte(wc * 32 + fr, fq * 8);
#define PG8_SA(b, h) (((b) * 2 + (h)) * HTB)
#define PG8_SB(b, h) ((4 + (b) * 2 + (h)) * HTB)
#define PG8_STAGE(bufoff, gbase, voff) do { _Pragma("unroll") for (int _i = 0; _i < 2; ++_i) \
        __builtin_amdgcn_global_load_lds((const unsigned*)((const char*)(gbase) + (voff)[_i]), (LAS unsigned*)(lds + (bufoff) + ldsw + _i * 8192), 16, 0, 0); } while (0)
#define PG8_LDA(dst, b, h) do { _Pragma("unroll") for (int m = 0; m < 4; ++m) _Pragma("unroll") for (int k = 0; k < 2; ++k) dst[m][k] = *(const LAS bf16x8*)(lds + PG8_SA(b, h) + aoff + m * 2048 + k * 1024); } while (0)
#define PG8_LDB(dst, b, h) do { _Pragma("unroll") for (int n = 0; n < 2; ++n) _Pragma("unroll") for (int k = 0; k < 2; ++k) dst[n][k] = *(const LAS bf16x8*)(lds + PG8_SB(b, h) + boff + n * 2048 + k * 1024); } while (0)
#define PG8_MMA(ai, bj, At, Bt) do { __builtin_amdgcn_s_setprio(1); _Pragma("unroll") for (int m = 0; m < 4; ++m) _Pragma("unroll") for (int n = 0; n < 2; ++n) _Pragma("unroll") for (int k = 0; k < 2; ++k) \
        acc[ai][bj][m][n] = __builtin_amdgcn_mfma_f32_16x16x32_bf16(Bt[n][k], At[m][k], acc[ai][bj][m][n], 0, 0, 0); __builtin_amdgcn_s_setprio(0); } while (0)
#define PG8_WAIT_V(n) asm volatile("s_waitcnt vmcnt(" #n ")" ::: "memory")
#define PG8_WAIT_L(n) asm volatile("s_waitcnt lgkmcnt(" #n ")" ::: "memory")
#define PG8_BAR __builtin_amdgcn_s_barrier()
#define PG8_SCHED __builtin_amdgcn_sched_barrier(0)
    Unit cur, nxt; int ui = 0;
    if (!S.next(0, cur)) return;
    f32x4 acc[2][2][4][2];
#pragma unroll
    for (int a = 0; a < 2; ++a)
#pragma unroll
        for (int b = 0; b < 2; ++b)
#pragma unroll
            for (int m = 0; m < 4; ++m)
#pragma unroll
                for (int n = 0; n < 2; ++n) acc[a][b][m][n] = (f32x4){0.f, 0.f, 0.f, 0.f};
    bf16x8 At[4][2], B0[2][2], B1[2][2];
    const char* cA = cur.A; const char* cB = cur.B;
    E.begin(cur, lds);
    PG8_STAGE(PG8_SB(0, 0), cB, voffB); PG8_STAGE(PG8_SA(0, 0), cA, voffA); PG8_STAGE(PG8_SB(0, 1), cB + hstepB, voffB); PG8_STAGE(PG8_SA(0, 1), cA + hstepA, voffA);
    if (wr == 1) PG8_BAR;
    PG8_WAIT_V(4); PG8_BAR;
    PG8_STAGE(PG8_SB(1, 0), cB + kstep, voffB); PG8_STAGE(PG8_SA(1, 0), cA + kstep, voffA); PG8_STAGE(PG8_SB(1, 1), cB + hstepB + kstep, voffB);
    PG8_WAIT_V(6); PG8_BAR;
    for (;;) {
        const bool has_next = S.next(ui + 1, nxt);
        const char* nA = has_next ? nxt.A : cA; const char* nB = has_next ? nxt.B : cB;
#pragma unroll 1
        for (int t = 0; t < nt; t += 2) {
            const bool last = (t == nt - 2);
            const char* a1 = cA + (size_t)(t + 1) * kstep;
            const char* a2 = last ? nA : cA + (size_t)(t + 2) * kstep;
            const char* b2 = last ? nB : cB + (size_t)(t + 2) * kstep + ((t + 2) >= jt ? jumpB : 0);
            const char* a3 = a2 + kstep; const char* b3 = b2 + kstep;
            PG8_LDB(B0, 0, 0); PG8_SCHED; PG8_LDA(At, 0, 0); PG8_STAGE(PG8_SA(1, 1), a1 + hstepA, voffA);
            PG8_WAIT_L(8); PG8_BAR; PG8_WAIT_L(0); PG8_MMA(0, 0, At, B0); PG8_BAR; PG8_SCHED;
            PG8_LDB(B1, 0, 1); PG8_STAGE(PG8_SB(0, 0), b2, voffB);
            PG8_BAR; PG8_WAIT_L(0); PG8_MMA(0, 1, At, B1); PG8_BAR;
            PG8_LDA(At, 0, 1); PG8_STAGE(PG8_SA(0, 0), a2, voffA);
            PG8_BAR; PG8_WAIT_L(0); PG8_MMA(1, 0, At, B0); PG8_BAR; PG8_SCHED;
            PG8_STAGE(PG8_SB(0, 1), b2 + hstepB, voffB);
            PG8_WAIT_V(6); PG8_BAR; PG8_MMA(1, 1, At, B1); PG8_BAR;
            PG8_LDB(B0, 1, 0); PG8_SCHED; PG8_LDA(At, 1, 0); PG8_STAGE(PG8_SA(0, 1), a2 + hstepA, voffA);
            PG8_WAIT_L(8); PG8_BAR; PG8_WAIT_L(0); PG8_MMA(0, 0, At, B0); PG8_BAR; PG8_SCHED;
            PG8_LDB(B1, 1, 1); PG8_STAGE(PG8_SB(1, 0), b3, voffB);
            PG8_BAR; PG8_WAIT_L(0); PG8_MMA(0, 1, At, B1); PG8_BAR;
            PG8_LDA(At, 1, 1); PG8_STAGE(PG8_SA(1, 0), a3, voffA);
            PG8_BAR; PG8_WAIT_L(0); PG8_MMA(1, 0, At, B0); PG8_BAR; PG8_SCHED;
            PG8_STAGE(PG8_SB(1, 1), b3 + hstepB, voffB);
            PG8_WAIT_V(6); PG8_BAR; PG8_MMA(1, 1, At, B1); PG8_BAR;
        }
        E(acc, cur, nxt, has_next, ui, lds, wr, wc);
        if (!has_next) break;
#pragma unroll
        for (int a = 0; a < 2; ++a)
#pragma unroll
            for (int b = 0; b < 2; ++b)
#pragma unroll
                for (int m = 0; m < 4; ++m)
#pragma unroll
                    for (int n = 0; n < 2; ++n) acc[a][b][m][n] = (f32x4){0.f, 0.f, 0.f, 0.f};
        cur = nxt; cA = nA; cB = nB; ++ui;
    }
    PG8_WAIT_V(0);
    if (wr == 0) PG8_BAR;
    PG8_BAR;
#undef PG8_SA
#undef PG8_SB
#undef PG8_STAGE
#undef PG8_LDA
#undef PG8_LDB
#undef PG8_MMA
#undef PG8_WAIT_V
#undef PG8_WAIT_L
#undef PG8_BAR
#undef PG8_SCHED
}

typedef f32x4 Acc[2][2][4][2];
DI int opaque_lane() { int l; asm volatile("v_mbcnt_lo_u32_b32 %0, -1, 0\n\tv_mbcnt_hi_u32_b32 %0, -1, %0" : "=v"(l)); return l; }
struct EpiBf16 {
    static constexpr bool APERM = false;
    DI void begin(const Unit&, LAS unsigned char*) const {}
    DI void operator()(Acc& acc, const Unit& u, const Unit&, bool, int, LAS unsigned char*, int wr, int wc) const {
        const int lane_ = opaque_lane(), fr = lane_ & 15, fq = lane_ >> 4;
        bf16_t* base = (bf16_t*)u.C + (size_t)(wr * 64 + fr) * u.ldc + wc * 64 + 8 * fq;
#pragma unroll
        for (int ai = 0; ai < 2; ++ai)
#pragma unroll
            for (int m = 0; m < 4; ++m) { bf16_t* rowp = base + (size_t)(ai * HALF + m * 16) * u.ldc;
#pragma unroll
                for (int bj = 0; bj < 2; ++bj) { const f32x4 v0 = acc[ai][bj][m][0], v1 = acc[ai][bj][m][1];
                    u32x4 w; w.x = pk_bf16(v0[0], v0[1]); w.y = pk_bf16(v0[2], v0[3]); w.z = pk_bf16(v1[0], v1[1]); w.w = pk_bf16(v1[2], v1[3]);
                    __builtin_nontemporal_store(w, (u32x4*)(rowp + bj * 32)); } }
    }
};
struct EpiInproj {
    static constexpr bool APERM = false;
    bf16_t* ut;
    DI void begin(const Unit&, LAS unsigned char*) const {}
    DI void operator()(Acc& acc, const Unit& u, const Unit&, bool, int, LAS unsigned char*, int wr, int wc) const {
        const int lane_ = opaque_lane(), fr = lane_ & 15, fq = lane_ >> 4;
        bf16_t* base = (bf16_t*)u.C + (size_t)(wr * 64 + fr) * u.ldc + wc * 64 + 8 * fq;
#pragma unroll
        for (int ai = 0; ai < 2; ++ai)
#pragma unroll
            for (int m = 0; m < 4; ++m) { bf16_t* rowp = base + (size_t)(ai * HALF + m * 16) * u.ldc;
#pragma unroll
                for (int bj = 0; bj < 2; ++bj) { const f32x4 v0 = acc[ai][bj][m][0], v1 = acc[ai][bj][m][1];
                    u32x4 w; w.x = pk_bf16(v0[0], v0[1]); w.y = pk_bf16(v0[2], v0[3]); w.z = pk_bf16(v1[0], v1[1]); w.w = pk_bf16(v1[2], v1[3]);
                    if (u.kind == 0 && u.pn * BM + wc * 64 < 384) {
                        const int col = u.pn * BM + wc * 64 + bj * 32 + 8 * fq, t = u.pm * BM + ai * HALF + wr * 64 + m * 16 + fr;
                        const unsigned o = (unsigned)((((((t >> 11) * 24 + (col >> 4)) * 64 + (t & 63)) * 32 + ((t >> 6) & 31)) * 16) + (col & 8));
                        *(u32x4*)(ut + o) = w;
                    } else __builtin_nontemporal_store(w, (u32x4*)(rowp + bj * 32)); } }
    }
};
struct EpiF32 {
    static constexpr bool APERM = false;
    DI void begin(const Unit&, LAS unsigned char*) const {}
    DI void operator()(Acc& acc, const Unit& u, const Unit&, bool, int, LAS unsigned char*, int wr, int wc) const {
        const int lane_ = opaque_lane(), fr = lane_ & 15, fq = lane_ >> 4;
        float* base = (float*)u.C + (size_t)(wr * 64 + fr) * u.ldc + wc * 64 + 8 * fq;
#pragma unroll
        for (int ai = 0; ai < 2; ++ai)
#pragma unroll
            for (int m = 0; m < 4; ++m) { float* rowp = base + (size_t)(ai * HALF + m * 16) * u.ldc;
#pragma unroll
                for (int bj = 0; bj < 2; ++bj) { *(f32x4*)(rowp + bj * 32) = acc[ai][bj][m][0]; *(f32x4*)(rowp + bj * 32 + 4) = acc[ai][bj][m][1]; } }
    }
};
struct EpiGlu {
    static constexpr bool APERM = false;
    const bf16_t* ypre; bf16_t* ycat;
    DI void begin(const Unit&, LAS unsigned char*) const {}
    DI void operator()(Acc& acc, const Unit& u, const Unit&, bool, int, LAS unsigned char*, int wr, int wc) const {
        if (u.pn * BM + wc * 64 >= 384) return;
#pragma unroll
        for (int ai = 0; ai < 2; ++ai)
#pragma unroll
            for (int bj = 0; bj < 2; ++bj)
#pragma unroll
                for (int m = 0; m < 4; ++m)
#pragma unroll
                    for (int n = 0; n < 2; ++n)
#pragma unroll
                        for (int j = 0; j < 4; ++j) acc[ai][bj][m][n][j] = sigmoidf_(acc[ai][bj][m][n][j]);
#pragma unroll
        for (int bj = 0; bj < 2; ++bj) {
            if (u.pn * BM + wc * 64 < 384) {
#pragma unroll
                for (int ai = 0; ai < 2; ++ai)
#pragma unroll
                    for (int m = 0; m < 4; ++m) {
                        const int lane_ = opaque_lane(), fr = lane_ & 15, fq = lane_ >> 4;
                        const unsigned row = (unsigned)(u.pm * BM + wr * 64 + fr + ai * HALF + m * 16), col = (unsigned)(u.pn * BM + wc * 64 + 8 * fq + bj * 32);
                        const u32x4 yp = *(const u32x4*)(ypre + (row * 384u + col));
                        const f32x4 v0 = acc[ai][bj][m][0], v1 = acc[ai][bj][m][1];
                        u32x4 w;
                        w.x = pk_bf16(bf_lo(yp.x) * v0[0], bf_hi(yp.x) * v0[1]);
                        w.y = pk_bf16(bf_lo(yp.y) * v0[2], bf_hi(yp.y) * v0[3]);
                        w.z = pk_bf16(bf_lo(yp.z) * v1[0], bf_hi(yp.z) * v1[1]);
                        w.w = pk_bf16(bf_lo(yp.w) * v1[2], bf_hi(yp.w) * v1[3]);
                        *(u32x4*)(ycat + (row * 1024u + col)) = w;
                    }
            }
        }
    }
};
struct EpiY {
    static constexpr bool APERM = false;
    bf16_t* y; float* rss;
    DI void begin(const Unit&, LAS unsigned char*) const {}
    DI void operator()(Acc& acc, const Unit& u, const Unit&, bool, int, LAS unsigned char*, int wr, int wc) const {
        const int lane_ = opaque_lane(), fr = lane_ & 15, fq = lane_ >> 4;
        const int row0 = u.pm * BM + wr * 64 + fr, col0 = u.pn * BM + wc * 64 + 8 * fq;
#pragma unroll
        for (int ai = 0; ai < 2; ++ai)
#pragma unroll
            for (int m = 0; m < 4; ++m) { const size_t row = (size_t)(row0 + ai * HALF + m * 16); float s = 0.f;
#pragma unroll
                for (int bj = 0; bj < 2; ++bj) { const f32x4 v0 = acc[ai][bj][m][0], v1 = acc[ai][bj][m][1];
                    s += (v0[0] * v0[0] + v0[1] * v0[1]) + (v0[2] * v0[2] + v0[3] * v0[3]) + (v1[0] * v1[0] + v1[1] * v1[1]) + (v1[2] * v1[2] + v1[3] * v1[3]);
                    u32x4 w; w.x = pk_bf16(v0[0], v0[1]); w.y = pk_bf16(v0[2], v0[3]); w.z = pk_bf16(v1[0], v1[1]); w.w = pk_bf16(v1[2], v1[3]);
                    __builtin_nontemporal_store(w, (u32x4*)(y + row * 1024 + col0 + bj * 32)); }
                s += bperm(s, lane_ ^ 16); s += bperm(s, lane_ ^ 32);
                if (fq == 0) rss[row * 16 + u.pn * 4 + wc] = s; }
    }
};
DI float dpp_prev(float cur, float prevreg) {
    const int t = __builtin_amdgcn_update_dpp(0, __float_as_int(prevreg), 0x121, 0xf, 0xf, false);
    return __int_as_float(__builtin_amdgcn_update_dpp(t, __float_as_int(cur), 0x111, 0xf, 0xf, false));
}
DI float dpp_next(float cur, float nextreg) {
    const int t = __builtin_amdgcn_update_dpp(0, __float_as_int(nextreg), 0x12f, 0xf, 0xf, false);
    return __int_as_float(__builtin_amdgcn_update_dpp(t, __float_as_int(cur), 0x101, 0xf, 0xf, false));
}
DI f32x4 dpp_shr1_v(const f32x4 v) { f32x4 r;
#pragma unroll
    for (int j = 0; j < 4; ++j) r[j] = __int_as_float(__builtin_amdgcn_update_dpp(__float_as_int(v[j]), __float_as_int(v[j]), 0x111, 0xf, 0xf, false));
    return r; }
DI f32x4 dpp_shl1_v(const f32x4 v) { f32x4 r;
#pragma unroll
    for (int j = 0; j < 4; ++j) r[j] = __int_as_float(__builtin_amdgcn_update_dpp(__float_as_int(v[j]), __float_as_int(v[j]), 0x101, 0xf, 0xf, false));
    return r; }
struct EpiUp {
    static constexpr bool APERM = true;
    bf16_t* act; bf16_t* edge; const float* cw; const float* cb;
    DI float ldw(const Unit& u, int idx) const { const int arr = idx >> 8, col = idx & 255, chn = (col >> 7) * 2816 + u.pn * 128 + (col & 127); return arr < 3 ? cw[arr * 5632 + chn] : cb[chn]; }
    DI void begin(const Unit& u, LAS unsigned char* lds) const {
        const int t = otid(); LAS float* wb = (LAS float*)(lds + STAGE_BYTES);
        wb[t] = ldw(u, t); wb[t + 512] = ldw(u, t + 512);
    }
    DI void operator()(Acc& acc, const Unit& u, const Unit& nx, bool has_next, int ui, LAS unsigned char* lds, int wr, int wc) const {
        const int t_ = otid();
        float pa = 0.f, pb = 0.f;
        if (has_next) { pa = ldw(nx, t_); pb = ldw(nx, t_ + 512); }
        const LAS float* wb = (const LAS float*)(lds + STAGE_BYTES) + (ui & 1) * 1024;
        {
            const int l_ = opaque_lane(), fr = l_ & 15, ch0 = u.pn * 128 + wc * 32 + 8 * (l_ >> 4);
            if (fr == 0 || fr == 15) {
                const int slot0 = fr == 0 ? 0 : 2;
#pragma unroll
                for (int ai = 0; ai < 2; ++ai) { const int seg = u.pm * 4 + ai * 2 + wr;
#pragma unroll
                    for (int bj = 0; bj < 2; ++bj)
#pragma unroll
                        for (int n = 0; n < 2; ++n) {
                            const f32x4 a = fr == 0 ? acc[ai][bj][0][n] : acc[ai][bj][2][n], b = fr == 0 ? acc[ai][bj][1][n] : acc[ai][bj][3][n];
                            u32x2 g2; g2.x = pk_bf16(a[0], a[1]); g2.y = pk_bf16(a[2], a[3]);
                            u32x2 h2; h2.x = pk_bf16(b[0], b[1]); h2.y = pk_bf16(b[2], b[3]);
                            *(u32x2*)(edge + (unsigned)(((seg * 4 + slot0) * 2 + bj) * DFF + ch0 + 4 * n)) = g2;
                            *(u32x2*)(edge + (unsigned)(((seg * 4 + slot0 + 1) * 2 + bj) * DFF + ch0 + 4 * n)) = h2; } }
            }
        }
#pragma unroll
        for (int bj = 0; bj < 2; ++bj)
#pragma unroll
            for (int n = 0; n < 2; ++n) {
                const int l_ = opaque_lane();
                const int wi = bj * 128 + wc * 32 + 8 * (l_ >> 4) + 4 * n;
                const f32x4 w0 = *(const LAS f32x4*)(wb + wi), w1 = *(const LAS f32x4*)(wb + 256 + wi), w2 = *(const LAS f32x4*)(wb + 512 + wi), bb = *(const LAS f32x4*)(wb + 768 + wi);
#pragma unroll
                for (int ai = 0; ai < 2; ++ai) {
                    const f32x4 X0 = acc[ai][bj][0][n], X1 = acc[ai][bj][1][n], X2 = acc[ai][bj][2][n], X3 = acc[ai][bj][3][n];
                    const f32x4 P = dpp_shr1_v(X3), N = dpp_shl1_v(X0);
                    f32x4 Y0 = w0 * P + w1 * X0 + w2 * X1 + bb, Y1 = w0 * X0 + w1 * X1 + w2 * X2 + bb, Y2 = w0 * X1 + w1 * X2 + w2 * X3 + bb, Y3 = w0 * X2 + w1 * X3 + w2 * N + bb;
                    if (bj == 0) {
#pragma unroll
                        for (int j = 0; j < 4; ++j) { Y0[j] = gelu_tanh(Y0[j]); Y1[j] = gelu_tanh(Y1[j]); Y2[j] = gelu_tanh(Y2[j]); Y3[j] = gelu_tanh(Y3[j]); }
                    }
                    acc[ai][bj][0][n] = Y0; acc[ai][bj][1][n] = Y1; acc[ai][bj][2][n] = Y2; acc[ai][bj][3][n] = Y3;
                }
                asm volatile("" ::: "memory");
            }
        {
            const int l_ = opaque_lane(), fr = l_ & 15, ch0 = u.pn * 128 + wc * 32 + 8 * (l_ >> 4);
#pragma unroll
            for (int ai = 0; ai < 2; ++ai)
#pragma unroll
                for (int m = 0; m < 4; ++m) {
                    const unsigned row = (unsigned)(u.pm * BM + ai * HALF + wr * 64 + 4 * fr + m);
                    const f32x4 g0 = acc[ai][0][m][0], v0 = acc[ai][1][m][0], g1 = acc[ai][0][m][1], v1 = acc[ai][1][m][1];
                    u32x4 w; w.x = pk_bf16(g0[0] * v0[0], g0[1] * v0[1]); w.y = pk_bf16(g0[2] * v0[2], g0[3] * v0[3]);
                    w.z = pk_bf16(g1[0] * v1[0], g1[1] * v1[1]); w.w = pk_bf16(g1[2] * v1[2], g1[3] * v1[3]);
                    __builtin_nontemporal_store(w, (u32x4*)(act + (row * (unsigned)DFF + (unsigned)ch0)));
                }
        }
        if (has_next) { LAS float* wn = (LAS float*)(lds + STAGE_BYTES) + ((ui + 1) & 1) * 1024; wn[t_] = pa; wn[t_ + 512] = pb; }
    }
};

struct SchedInproj {
    const char* h; const char* win; const char* wpq; char* z; char* pqt; TileMap m1, m2; int bid;
    DI bool next(int i, Unit& u) const {
        const int L = i * (int)gridDim.x + bid; if (L >= 768) return false;
        int pm, pn;
        if (L < 512) { m1.get(L, pm, pn); u.A = h + (size_t)pm * 256 * 1024 * 2; u.B = win + (size_t)pn * 256 * 1024 * 2; u.C = z + ((size_t)pm * 256 * 1024 + pn * 256) * 2; u.ldc = 1024; u.kind = 0; }
        else { m2.get(L - 512, pm, pn); u.A = wpq + (size_t)pm * 256 * 1024 * 2; u.B = h + (size_t)pn * 256 * 1024 * 2; u.C = pqt + ((size_t)pm * 256 * MTOK + pn * 256) * 2; u.ldc = MTOK; u.kind = 1; }
        u.pm = pm; u.pn = pn; return true;
    }
};
struct SchedPlain {
    const char* A; const char* B; int K; int total; TileMap tm; int bid;
    DI bool next(int i, Unit& u) const {
        const int L = i * (int)gridDim.x + bid; if (L >= total) return false;
        int pm, pn; tm.get(L, pm, pn);
        u.A = A + (size_t)pm * 256 * K * 2; u.B = B + (size_t)pn * 256 * K * 2; u.C = nullptr; u.ldc = 0; u.pm = pm; u.pn = pn; u.kind = 0; return true;
    }
};
struct SchedOne { Unit u0; DI bool next(int i, Unit& u) const { if (i > 0) return false; u = u0; return true; } };

DI void tconv_tile(LAS float* tile, const float* src, int ld_src, int k0, int srccol, bf16_t* dst, int ldd, int n0, int srccol_hi = -2) {
    const int tid = otid();
    __syncthreads();
#pragma unroll
    for (int i = 0; i < 8; ++i) { const int k = (tid >> 6) + 8 * i, n = tid & 63;
        const int sc2 = (srccol_hi != -2 && n >= 32) ? srccol_hi + (n - 32) : srccol + n;
        tile[k * 65 + n] = srccol >= 0 ? src[(size_t)(k0 + k) * ld_src + sc2] : 0.f; }
    __syncthreads();
    const int n = tid >> 3, kc = (tid & 7) * 8;
    float v[8];
#pragma unroll
    for (int j = 0; j < 8; ++j) v[j] = tile[(kc + j) * 65 + n];
    u32x4 w; w.x = pk_bf16(v[0], v[1]); w.y = pk_bf16(v[2], v[3]); w.z = pk_bf16(v[4], v[5]); w.w = pk_bf16(v[6], v[7]);
    *(u32x4*)(dst + (size_t)(n0 + n) * ldd + k0 + kc) = w;
}

DI void phase_prep(const Params& p, LAS unsigned char* lds) {
    const int tid = otid(), nblk = gridDim.x, bid = obid();
    LAS float* tile = (LAS float*)lds;
    for (int l = 0; l < NL; ++l) {
        unsigned char* wl = p.ws + l * LAYER_W;
        const float* w_in = p.in[I_WIN] + (size_t)l * 1024 * 1280;
        const float* w_glu = p.in[I_WGLU] + (size_t)l * 384 * 384;
        const float* w_out = p.in[I_WOUT] + (size_t)l * 1024 * 1024;
        const float* w_up = p.in[I_WUP] + (size_t)l * 1024 * 5632;
        const float* w_dn = p.in[I_WDOWN] + (size_t)l * 2816 * 1024;
        const float* w_fft = p.in[I_WFFT] + (size_t)l * 4 * 64 * 64;
        for (int j = bid; j < 2608; j += nblk) {
            if (j < 256) { const int kc = j >> 4, nc = j & 15; tconv_tile(tile, w_in, 1280, kc * 64, (nc < 6 ? nc : nc + 4) * 64, (bf16_t*)(wl + O_WIN), 1024, nc * 64); }
            else if (j < 304) { const int q = j - 256, kc = q >> 3, nc = q & 7; tconv_tile(tile, w_glu, 384, kc * 64, nc < 6 ? nc * 64 : -1, (bf16_t*)(wl + O_WGLU), 384, nc * 64); }
            else if (j < 496) { const int q = j - 304; int kc = q >> 4; const int nc = q & 15; kc = kc < 6 ? kc : kc + 4; tconv_tile(tile, w_out, 1024, kc * 64, nc * 64, (bf16_t*)(wl + O_WOUT), 1024, nc * 64); }
            else if (j < 1904) { const int q = j - 496, kc = q / 88, nc = q % 88, pn = nc >> 2, w4 = nc & 3;
                tconv_tile(tile, w_up, 5632, kc * 64, pn * 128 + w4 * 32, (bf16_t*)(wl + O_WUP), 1024, nc * 64, 2816 + pn * 128 + w4 * 32); }
            else { const int q = j - 1904, kc = q >> 4, nc = q & 15; tconv_tile(tile, w_dn, 1024, kc * 64, nc * 64, (bf16_t*)(wl + O_WDN), 2816, nc * 64); }
        }
        for (int j = (bid + nblk - 64 - 128 * l) % nblk; j < 64; j += nblk) {
            const int kc = j >> 2, hh = j & 3;
            __syncthreads();
#pragma unroll
            for (int i = 0; i < 8; ++i) { const int k = (tid >> 6) + 8 * i, d = tid & 63; tile[k * 65 + d] = w_in[(size_t)(kc * 64 + k) * 1280 + 384 + hh * 64 + d]; }
            LAS float* tab = tile + 64 * 65;
            if (tid < 64) { float s, c; sincospif((float)tid / 32.0f, &s, &c); tab[tid] = c * 0.125f; tab[64 + tid] = s * 0.125f; }
            __syncthreads();
            const int r = tid >> 2, part = r >> 6, e = r & 63, kg = (tid & 3) * 16;
            float o[16];
#pragma unroll
            for (int q = 0; q < 16; ++q) o[q] = 0.f;
            for (int d = 0; d < 64; ++d) { const float tv = tab[part * 64 + ((d * e) & 63)];
#pragma unroll
                for (int q = 0; q < 16; ++q) o[q] += tile[(kg + q) * 65 + d] * tv; }
            bf16_t* dst = (bf16_t*)(wl + O_WPQ) + (size_t)(part * 256 + hh * 64 + e) * 1024 + kc * 64 + kg;
            u32x4 w0, w1; w0.x = pk_bf16(o[0], o[1]); w0.y = pk_bf16(o[2], o[3]); w0.z = pk_bf16(o[4], o[5]); w0.w = pk_bf16(o[6], o[7]);
            w1.x = pk_bf16(o[8], o[9]); w1.y = pk_bf16(o[10], o[11]); w1.z = pk_bf16(o[12], o[13]); w1.w = pk_bf16(o[14], o[15]);
            *(u32x4*)dst = w0; *(u32x4*)(dst + 8) = w1;
        }
        for (int j = (bid + nblk - 128 - 128 * l + 2 * nblk) % nblk; j < 64; j += nblk) {
            const int hh = j >> 4, nc = j & 15;
            LAS float* tf = tile + 64 * 65;
            __syncthreads();
#pragma unroll
            for (int i = 0; i < 8; ++i) { const int e = (tid >> 6) + 8 * i, n = tid & 63;
                tile[e * 65 + n] = w_out[(size_t)(384 + hh * 64 + e) * 1024 + nc * 64 + n];
                tf[e * 65 + n] = w_fft[(size_t)hh * 4096 + e * 64 + n]; }
            __syncthreads();
            const int n = tid >> 3, dg = (tid & 7) * 8;
            float o[8];
#pragma unroll
            for (int q = 0; q < 8; ++q) o[q] = 0.f;
            for (int e = 0; e < 64; ++e) { const float wv = tile[e * 65 + n];
#pragma unroll
                for (int q = 0; q < 8; ++q) o[q] += tf[(dg + q) * 65 + e] * wv; }
            u32x4 w; w.x = pk_bf16(o[0], o[1]); w.y = pk_bf16(o[2], o[3]); w.z = pk_bf16(o[4], o[5]); w.w = pk_bf16(o[6], o[7]);
            *(u32x4*)((bf16_t*)(wl + O_WOUT) + (size_t)(nc * 64 + n) * 1024 + 384 + hh * 64 + dg) = w;
        }
        {
            const float* lam_re = p.in[I_LAMRE] + (size_t)l * 2 * 24 * 64; const float* lam_im = p.in[I_LAMIM] + (size_t)l * 2 * 24 * 64;
            const float* log_dt = p.in[I_LOGDT] + (size_t)l * 2 * 24;
            const float* b_re = p.in[I_BRE] + (size_t)l * 2 * 24 * 64 * 16; const float* b_im = p.in[I_BIM] + (size_t)l * 2 * 24 * 64 * 16;
            const float* c_re = p.in[I_CRE] + (size_t)l * 24 * 16 * 64; const float* c_im = p.in[I_CIM] + (size_t)l * 24 * 16 * 64;
            float* sa = (float*)(wl + O_SA); bf16_t* sb = (bf16_t*)(wl + O_SB); bf16_t* sc = (bf16_t*)(wl + O_SC);
            for (int idx = bid * NTHREADS + tid; idx < 2 * 24 * 64; idx += nblk * NTHREADS) {
                const int pp = idx & 63, g = (idx >> 6) % 24, dir = idx / (64 * 24);
                const float lr = lam_re[idx], li = lam_im[idx], dt = expf(log_dt[dir * 24 + g]);
                const float mag = expf(lr * dt); float sn, cs; sincosf(li * dt, &sn, &cs);
                const float ar = mag * cs, ai = mag * sn;
                sa[((dir * 24 + g) * 2 + 0) * 64 + pp] = ar; sa[((dir * 24 + g) * 2 + 1) * 64 + pp] = ai;
                const float xr = ar - 1.0f, xi = ai, den = 1.0f / (lr * lr + li * li);
                const float fr_ = (xr * lr + xi * li) * den, fi_ = (xi * lr - xr * li) * den;
                for (int ch = 0; ch < 16; ++ch) {
                    const float br = b_re[(size_t)idx * 16 + ch], bi = b_im[(size_t)idx * 16 + ch];
                    const float vr = fr_ * br - fi_ * bi, vi = fr_ * bi + fi_ * br;
                    const int lane = (pp & 31) + 32 * (ch >> 3), j = ch & 7, pt = pp >> 5;
                    sb[((size_t)((dir * 24 + g) * 4 + 0 + pt) * 64 + lane) * 8 + j] = f2bf(vr);
                    sb[((size_t)((dir * 24 + g) * 4 + 2 + pt) * 64 + lane) * 8 + j] = f2bf(vi);
                }
                {
                    const int pt = pp >> 5, p5 = pp & 31, s = p5 >> 4, rem = p5 & 15, hh = (rem >> 2) & 1, j = ((rem >> 3) << 2) | (rem & 3);
                    for (int r = 0; r < 32; ++r) {
                        const float c_r = c_re[((size_t)g * 16 + (r & 15)) * 64 + pp], c_i = c_im[((size_t)g * 16 + (r & 15)) * 64 + pp];
                        const float cr = r < 16 ? c_r : c_r * ar - c_i * ai, ci = r < 16 ? -c_i : -(c_r * ai + c_i * ar);
                        const int lane = r + 32 * hh;
                        sc[((size_t)(((dir * 24 + g) * 4 + 0 + pt) * 2 + s) * 64 + lane) * 8 + j] = f2bf(cr);
                        sc[((size_t)(((dir * 24 + g) * 4 + 2 + pt) * 2 + s) * 64 + lane) * 8 + j] = f2bf(ci);
                    }
                }
            }
            bf16_t* cbt = (bf16_t*)(wl + O_CB);
            {
                const int lane_ = tid & 63;
                for (int w = bid * 8 + (tid >> 6); w < 2 * 24 * 256; w += nblk * 8) {
                    const int c = w & 15, ch = (w >> 4) & 15, g = (w >> 8) % 24, dir = w / (256 * 24);
                    const int li = (dir * 24 + g) * 64 + lane_;
                    const float dt = expf(log_dt[dir * 24 + g]), lr = lam_re[li], li_ = lam_im[li];
                    const float mag = expf(lr * dt); float sn, cs; sincosf(li_ * dt, &sn, &cs);
                    const float xr = mag * cs - 1.0f, xi = mag * sn, den = 1.0f / (lr * lr + li_ * li_);
                    const float f_r = (xr * lr + xi * li_) * den, f_i = (xi * lr - xr * li_) * den;
                    const float br = b_re[(size_t)li * 16 + c], bi = b_im[(size_t)li * 16 + c];
                    const float vr = f_r * br - f_i * bi, vi = f_r * bi + f_i * br;
                    float acc = c_re[((size_t)g * 16 + ch) * 64 + lane_] * vr - c_im[((size_t)g * 16 + ch) * 64 + lane_] * vi;
                    acc += bperm(acc, lane_ ^ 32); acc += bperm(acc, lane_ ^ 16); acc += bperm(acc, lane_ ^ 8); acc += bperm(acc, lane_ ^ 4); acc += bperm(acc, lane_ ^ 2); acc += bperm(acc, lane_ ^ 1);
                    if (lane_ == 0) { const size_t base = ((size_t)(dir * 24 + g) * 64 + 32 * (c >> 3)) * 8 + (c & 7);
                        cbt[base + (size_t)(16 + ch) * 8] = f2bf(acc); cbt[base + (size_t)ch * 8] = 0; }
                }
            }
        }
    }
    {
        bf16_t* dft = (bf16_t*)(p.ws + O_DFT);
        const float sc_ = 0.02209708691f;
        for (int idx = bid * NTHREADS + tid; idx < 2048 * 256; idx += nblk * NTHREADS) {
            const int row = idx >> 8, k8 = (idx & 255) * 8, j = (row & 1023) + 1;
            float v[8];
#pragma unroll
            for (int q = 0; q < 8; ++q) { const int m = (j * (k8 + q)) & 2047; float sn, cs; sincospif((float)m * (1.0f / 1024.0f), &sn, &cs); v[q] = (row < 1024 ? cs : sn) * sc_; }
            u32x4 w; w.x = pk_bf16(v[0], v[1]); w.y = pk_bf16(v[2], v[3]); w.z = pk_bf16(v[4], v[5]); w.w = pk_bf16(v[6], v[7]);
            *(u32x4*)(dft + (size_t)row * 2048 + k8) = w;
        }
    }
    {
        float* mod = (float*)(p.ws + O_MOD);
        LAS float* cl = (LAS float*)lds;
        LAS float* red = cl + 16 * 1024;
        for (int j = (bid + nblk - 32) % nblk; j < 192; j += nblk) {
            const int l = j / 96, c0 = (j % 96) * 64;
            __syncthreads();
            for (int i = tid; i < 16 * 1024; i += NTHREADS) cl[i] = p.in[I_C][i];
            __syncthreads();
            const int kg = tid >> 6, col = tid & 63;
            const float* w = p.in[I_WADA] + (size_t)l * 1024 * 6144 + c0 + col;
            float a[16];
#pragma unroll
            for (int b = 0; b < 16; ++b) a[b] = 0.f;
            for (int k0 = kg * 128; k0 < kg * 128 + 128; k0 += 16) {
                float wv[16];
#pragma unroll
                for (int q = 0; q < 16; ++q) wv[q] = w[(size_t)(k0 + q) * 6144];
#pragma unroll
                for (int q = 0; q < 16; ++q)
#pragma unroll
                    for (int b = 0; b < 16; ++b) a[b] += cl[b * 1024 + k0 + q] * wv[q];
            }
#pragma unroll
            for (int b = 0; b < 16; ++b) red[(kg * 16 + b) * 64 + col] = a[b];
            __syncthreads();
            for (int o = tid; o < 16 * 64; o += NTHREADS) { const int b = o >> 6, cc = o & 63; float s = p.in[I_BADA][l * 6144 + c0 + cc];
#pragma unroll
                for (int q = 0; q < 8; ++q) s += red[(q * 16 + b) * 64 + cc];
                mod[((size_t)l * 16 + b) * 6144 + c0 + cc] = s; }
        }
    }
}

DI float wave_sum(float v, int lane) {
    v += bperm(v, lane ^ 32); v += bperm(v, lane ^ 16); v += bperm(v, lane ^ 8); v += bperm(v, lane ^ 4); v += bperm(v, lane ^ 2); v += bperm(v, lane ^ 1); return v; }
template <bool XB>
DI void phase_rows(const float* xin, const bf16_t* xin_b, float* xout, bf16_t* xout_b, const bf16_t* y, const float* rss, const float* modr, int gate_off, const float* g_post, bool do_res,
                   bool do_h, const float* modh, int sh_off, int sc_off, const float* g_pre, bf16_t* hout) {
    const int tid_ = otid(), lane = tid_ & 63, wid = tid_ >> 6;
#define RCOL(i) (lane * 8 + 512 * ((i) >> 1) + 4 * ((i) & 1))
    f32x4 gp[4], gq[4];
#pragma unroll
    for (int i = 0; i < 4; ++i) { const int c = RCOL(i); gp[i] = do_res ? *(const f32x4*)(g_post + c) : (f32x4){0.f, 0.f, 0.f, 0.f}; gq[i] = do_h ? *(const f32x4*)(g_pre + c) : (f32x4){0.f, 0.f, 0.f, 0.f}; }
    const int rstride = (int)gridDim.x * 32;
    u32x4 xr[4][2], yr[4][2]; float rsr[4];
#define ROWS_LOAD_RAW(R0) do { _Pragma("unroll") for (int r = 0; r < 4; ++r) { _Pragma("unroll") for (int h = 0; h < 2; ++h) { \
        xr[r][h] = *(const u32x4*)(xin_b + (size_t)((R0) + r) * 1024 + lane * 8 + 512 * h); yr[r][h] = *(const u32x4*)(y + (size_t)((R0) + r) * 1024 + lane * 8 + 512 * h); } \
        rsr[r] = rss[(size_t)((R0) + r) * 16 + (lane & 15)]; } } while (0)
    const int row_first = (obid() * 8 + wid) * 4;
    if (XB) { if (row_first < MTOK) ROWS_LOAD_RAW(row_first); }
    for (int row0 = row_first; row0 < MTOK; row0 += rstride) {
        const int b = row0 >> 11;
        f32x4 x[4][4]; u32x4 yw[4][2]; float rs[4];
        if (XB) {
#pragma unroll
            for (int r = 0; r < 4; ++r) {
#pragma unroll
                for (int h = 0; h < 2; ++h) { const u32x4 w = xr[r][h]; yw[r][h] = yr[r][h];
                    x[r][2 * h] = (f32x4){bf_lo(w.x), bf_hi(w.x), bf_lo(w.y), bf_hi(w.y)}; x[r][2 * h + 1] = (f32x4){bf_lo(w.z), bf_hi(w.z), bf_lo(w.w), bf_hi(w.w)}; }
                rs[r] = rsr[r]; }
            if (row0 + rstride < MTOK) ROWS_LOAD_RAW(row0 + rstride);
        } else {
#pragma unroll
            for (int r = 0; r < 4; ++r)
#pragma unroll
                for (int i = 0; i < 4; ++i) x[r][i] = *(const f32x4*)(xin + (size_t)(row0 + r) * 1024 + RCOL(i));
        }
        if (do_res) {
            if (!XB) {
#pragma unroll
                for (int r = 0; r < 4; ++r) {
#pragma unroll
                    for (int h = 0; h < 2; ++h) yw[r][h] = *(const u32x4*)(y + (size_t)(row0 + r) * 1024 + lane * 8 + 512 * h);
                    rs[r] = rss[(size_t)(row0 + r) * 16 + (lane & 15)];
                }
            }
            float rstdy[4];
#pragma unroll
            for (int r = 0; r < 4; ++r) { float ss = rs[r]; ss += bperm(ss, lane ^ 1); ss += bperm(ss, lane ^ 2); ss += bperm(ss, lane ^ 4); ss += bperm(ss, lane ^ 8); rstdy[r] = rsqrtf(ss * (1.0f / 1024.0f) + 1e-6f); }
#pragma unroll
            for (int h = 0; h < 2; ++h) {
                const f32x4 gt0 = *(const f32x4*)(modr + (size_t)b * 6144 + gate_off + RCOL(2 * h)) * gp[2 * h], gt1 = *(const f32x4*)(modr + (size_t)b * 6144 + gate_off + RCOL(2 * h + 1)) * gp[2 * h + 1];
#pragma unroll
                for (int r = 0; r < 4; ++r) {
                    const u32x4 w = yw[r][h]; const float rstd = rstdy[r];
                    f32x4& a = x[r][2 * h]; f32x4& c2 = x[r][2 * h + 1];
                    a[0] += gt0[0] * (bf_lo(w.x) * rstd); a[1] += gt0[1] * (bf_hi(w.x) * rstd); a[2] += gt0[2] * (bf_lo(w.y) * rstd); a[3] += gt0[3] * (bf_hi(w.y) * rstd);
                    c2[0] += gt1[0] * (bf_lo(w.z) * rstd); c2[1] += gt1[1] * (bf_hi(w.z) * rstd); c2[2] += gt1[2] * (bf_lo(w.w) * rstd); c2[3] += gt1[3] * (bf_hi(w.w) * rstd);
                    if (xout_b) { u32x4 o; o.x = pk_bf16(a[0], a[1]); o.y = pk_bf16(a[2], a[3]); o.z = pk_bf16(c2[0], c2[1]); o.w = pk_bf16(c2[2], c2[3]);
                        *(u32x4*)(xout_b + (size_t)(row0 + r) * 1024 + lane * 8 + 512 * h) = o;
                        a = (f32x4){bf_lo(o.x), bf_hi(o.x), bf_lo(o.y), bf_hi(o.y)}; c2 = (f32x4){bf_lo(o.z), bf_hi(o.z), bf_lo(o.w), bf_hi(o.w)}; }
                    else { *(f32x4*)(xout + (size_t)(row0 + r) * 1024 + RCOL(2 * h)) = a; *(f32x4*)(xout + (size_t)(row0 + r) * 1024 + RCOL(2 * h + 1)) = c2; }
                }
            }
        }
        if (do_h) {
            float rstd[4];
#pragma unroll
            for (int r = 0; r < 4; ++r) { float ss = 0.f;
#pragma unroll
                for (int i = 0; i < 4; ++i) ss += (x[r][i][0] * x[r][i][0] + x[r][i][1] * x[r][i][1]) + (x[r][i][2] * x[r][i][2] + x[r][i][3] * x[r][i][3]);
                rstd[r] = rsqrtf(wave_sum(ss, lane) * (1.0f / 1024.0f) + 1e-6f); }
#pragma unroll
            for (int h = 0; h < 2; ++h) {
                f32x4 gg[2], sh[2];
#pragma unroll
                for (int q = 0; q < 2; ++q) { const int c = RCOL(2 * h + q);
                    const f32x4 sc = *(const f32x4*)(modh + (size_t)b * 6144 + sc_off + c); sh[q] = *(const f32x4*)(modh + (size_t)b * 6144 + sh_off + c); gg[q] = gq[2 * h + q] * (sc + 1.0f); }
#pragma unroll
                for (int r = 0; r < 4; ++r) {
                    const f32x4 a = x[r][2 * h] * rstd[r] * gg[0] + sh[0], c2 = x[r][2 * h + 1] * rstd[r] * gg[1] + sh[1];
                    u32x4 o; o.x = pk_bf16(a[0], a[1]); o.y = pk_bf16(a[2], a[3]); o.z = pk_bf16(c2[0], c2[1]); o.w = pk_bf16(c2[2], c2[3]);
                    *(u32x4*)(hout + (size_t)(row0 + r) * 1024 + lane * 8 + 512 * h) = o; }
            }
        }
    }
#undef RCOL
#undef ROWS_LOAD_RAW
}

DI bf16x8 ld_u(const bf16_t* p) { return *(const bf16x8*)p; }
DI void ssm_item(const Params& p, LAS unsigned char* lds, int l, int item) {
    const int tid = otid(), wid = tid >> 6, lane = tid & 63, n = lane & 31, hh = lane >> 5;
    const int g = item >> 2, b = (item & 3) * 4 + (wid >> 1), dir = wid & 1;
    unsigned char* wl = p.ws + l * LAYER_W;
    const u32x4 ctab0 = *(const u32x4*)(wl + O_SC + (size_t)g * 8192 + tid * 16), ctab1 = *(const u32x4*)(wl + O_SC + (size_t)(24 + g) * 8192 + tid * 16);
    const f32x4 atab = *(const f32x4*)((const float*)(wl + O_SA) + (size_t)g * 128 + ((tid & 63) >> 5) * 24 * 128 + (tid & 31) * 4);
    __syncthreads();
    *(LAS u32x4*)(lds + tid * 16) = ctab0; *(LAS u32x4*)(lds + 8192 + tid * 16) = ctab1;
    if (tid < 64) *(LAS f32x4*)(lds + 16384 + tid * 16) = atab;
    __syncthreads();
    const LAS float* la = (const LAS float*)(lds + 16384) + dir * 128 + 4 * hh;
#define SSM_LDA(pt) f32x16 are_, aim_; _Pragma("unroll") for (int q_ = 0; q_ < 4; ++q_) { const f32x4 r4 = *(const LAS f32x4*)(la + (pt) * 32 + 8 * q_), i4 = *(const LAS f32x4*)(la + 64 + (pt) * 32 + 8 * q_); \
        _Pragma("unroll") for (int j_ = 0; j_ < 4; ++j_) { are_[4 * q_ + j_] = r4[j_]; aim_[4 * q_ + j_] = i4[j_]; } }
    bf16x8 bop[4];
#pragma unroll
    for (int t = 0; t < 4; ++t) bop[t] = *(const bf16x8*)((const bf16_t*)(wl + O_SB) + ((size_t)((dir * 24 + g) * 4 + t) * 64 + lane) * 8);
    const bf16_t* ut = (const bf16_t*)(p.ws + O_UT) + (size_t)(b * 24 + g) * (64 * 32 * 16);
    const long tstride = dir ? -512 : 512;
    const bf16_t* ubase = ut + (dir ? (63 * 32 + (31 - n)) * 16 : n * 16) + 8 * hh;
    f32x16 hre[2], him[2];
#pragma unroll
    for (int pt = 0; pt < 2; ++pt)
#pragma unroll
        for (int i = 0; i < 16; ++i) { hre[pt][i] = 0.f; him[pt][i] = 0.f; }
    {
        const int widu = __builtin_amdgcn_readfirstlane(wid);
        LAS unsigned char* ust = lds + 20480 + widu * 16384;
#pragma unroll
        for (int q = 0; q < 8; ++q) __builtin_amdgcn_global_load_lds((const unsigned*)(ubase + q * tstride), (LAS unsigned*)(ust + q * 1024), 16, 0, 0);
        for (int i0 = 0; i0 < 64; i0 += 8) {
            const int cur = (i0 >> 3) & 1;
            asm volatile("s_waitcnt vmcnt(0)" ::: "memory");
            if (i0 + 8 < 64) {
#pragma unroll
                for (int q = 0; q < 8; ++q) __builtin_amdgcn_global_load_lds((const unsigned*)(ubase + (i0 + 8 + q) * tstride), (LAS unsigned*)(ust + (cur ^ 1) * 8192 + q * 1024), 16, 0, 0);
            }
#pragma unroll
            for (int q = 0; q < 8; ++q) {
                const bf16x8 uc = *(const LAS bf16x8*)(ust + cur * 8192 + q * 1024 + lane * 16);
#pragma unroll
                for (int pt = 0; pt < 2; ++pt) {
                    asm volatile("" ::: "memory");
                    SSM_LDA(pt)
                    const f32x16 tr = are_ * hre[pt] - aim_ * him[pt], ti = are_ * him[pt] + aim_ * hre[pt];
                    hre[pt] = MFMA32(bop[pt], uc, tr); him[pt] = MFMA32(bop[2 + pt], uc, ti);
                }
            }
        }
    }
#pragma unroll
    for (int pt = 0; pt < 2; ++pt) {
        SSM_LDA(pt)
        f32x16 pr = are_, pi = aim_;
#pragma unroll
        for (int s = 0; s < 6; ++s) { const f32x16 nr = pr * pr - pi * pi, ni = 2.0f * pr * pi; pr = nr; pi = ni; }
#pragma unroll
        for (int d = 1; d < 32; d <<= 1) {
            const bool take = n >= d; const int src = take ? lane - d : lane;
#pragma unroll
            for (int i = 0; i < 16; ++i) {
                const float sr = bperm(hre[pt][i], src), si = bperm(him[pt][i], src);
                if (take) { hre[pt][i] += pr[i] * sr - pi[i] * si; him[pt][i] += pr[i] * si + pi[i] * sr; }
            }
            const f32x16 nr = pr * pr - pi * pi, ni = 2.0f * pr * pi; pr = nr; pi = ni;
        }
#pragma unroll
        for (int i = 0; i < 16; ++i) { const int src1 = n ? lane - 1 : lane; const float sr = bperm(hre[pt][i], src1), si = bperm(him[pt][i], src1); hre[pt][i] = n ? sr : 0.f; him[pt][i] = n ? si : 0.f; }
        asm volatile("" ::: "memory");
    }
    {
        float* yt = (float*)(p.ws + O_YFB) + (size_t)dir * MTOK * 384 + (size_t)(b * 24 + g) * (64 * 32 * 16);
        float* ybase = yt + (dir ? (63 * 32 + (31 - n)) * 16 : n * 16) + 4 * hh;
        const int widu = __builtin_amdgcn_readfirstlane(wid);
        const bf16x8 cbop = *(const bf16x8*)((const bf16_t*)(wl + O_CB) + ((size_t)(dir * 24 + g) * 64 + lane) * 8);
        f32x16 yacc;
#pragma unroll
        for (int i = 0; i < 16; ++i) yacc[i] = 0.f;
        LAS unsigned char* ust = lds + 20480 + widu * 16384;
#pragma unroll
        for (int q = 0; q < 8; ++q) __builtin_amdgcn_global_load_lds((const unsigned*)(ubase + q * tstride), (LAS unsigned*)(ust + q * 1024), 16, 0, 0);
        for (int i0 = 0; i0 < 64; i0 += 8) {
            const int cur = (i0 >> 3) & 1;
            asm volatile("s_waitcnt vmcnt(0)" ::: "memory");
            if (i0 + 8 < 64) {
#pragma unroll
                for (int q = 0; q < 8; ++q) __builtin_amdgcn_global_load_lds((const unsigned*)(ubase + (i0 + 8 + q) * tstride), (LAS unsigned*)(ust + (cur ^ 1) * 8192 + q * 1024), 16, 0, 0);
            }
#pragma unroll
            for (int q = 0; q < 8; ++q) {
                const bf16x8 uc = *(const LAS bf16x8*)(ust + cur * 8192 + q * 1024 + lane * 16);
#pragma unroll
                for (int pt = 0; pt < 2; ++pt) {
                    asm volatile("" ::: "memory");
                    SSM_LDA(pt)
                    const f32x16 tr = are_ * hre[pt] - aim_ * him[pt], ti = are_ * him[pt] + aim_ * hre[pt];
                    hre[pt] = MFMA32(bop[pt], uc, tr); him[pt] = MFMA32(bop[2 + pt], uc, ti);
                }
                if ((q & 1) == 0) {
                    f32x16 yac2;
#pragma unroll
                    for (int i = 0; i < 16; ++i) { yacc[i] = 0.f; yac2[i] = 0.f; }
#pragma unroll
                    for (int T = 0; T < 2; ++T) {
#pragma unroll
                        for (int s = 0; s < 2; ++s) {
                            const f32x16 hv = hre[T], hw = him[T];
                            const bf16x8 hb = pack8(hv[8 * s], hv[8 * s + 1], hv[8 * s + 2], hv[8 * s + 3], hv[8 * s + 4], hv[8 * s + 5], hv[8 * s + 6], hv[8 * s + 7]);
                            const bf16x8 hc = pack8(hw[8 * s], hw[8 * s + 1], hw[8 * s + 2], hw[8 * s + 3], hw[8 * s + 4], hw[8 * s + 5], hw[8 * s + 6], hw[8 * s + 7]);
                            const bf16x8 cop = *(const LAS bf16x8*)(lds + dir * 8192 + ((T * 2 + s) * 64 + lane) * 16);
                            const bf16x8 coq = *(const LAS bf16x8*)(lds + dir * 8192 + (((2 + T) * 2 + s) * 64 + lane) * 16);
                            yacc = MFMA32(cop, hb, yacc);
                            yac2 = MFMA32(coq, hc, yac2);
                        }
                    }
                    yacc += yac2;
                    float* yp = ybase + (i0 + q) * tstride;
                    *(f32x4*)yp = (f32x4){yacc[0], yacc[1], yacc[2], yacc[3]};
                    *(f32x4*)(yp + 8) = (f32x4){yacc[4], yacc[5], yacc[6], yacc[7]};
                } else {
                    yacc = MFMA32(cbop, uc, yacc);
                    float* yp = ybase + (i0 + q) * tstride;
                    *(f32x4*)yp = (f32x4){yacc[8], yacc[9], yacc[10], yacc[11]};
                    *(f32x4*)(yp + 8) = (f32x4){yacc[12], yacc[13], yacc[14], yacc[15]};
                }
            }
        }
    }
    __syncthreads();
    {
        const float* yf = (const float*)(p.ws + O_YFB) + (size_t)(b * 24 + g) * (64 * 32 * 16); const float* yb = yf + (size_t)MTOK * 384;
        bf16_t* ypre = (bf16_t*)(p.ws + O_YPRE);
        const float* dsk = p.in[I_DSKIP] + l * 384 + g * 16;
        const int t2 = tid & 127;
        const f32x4 d4 = *(const f32x4*)(dsk + (t2 & 3) * 4);
        for (int it = 0; it < 64; it += 8) {
            f32x4 a[8], bb[8]; u32x2 uw[8];
#pragma unroll
            for (int q = 0; q < 8; ++q) { const int idx = t2 + 128 * (it + q), c4 = (idx & 3) * 4, nn = (idx >> 2) & 31, ii = idx >> 7, e = (ii * 32 + nn) * 16 + c4;
                a[q] = *(const f32x4*)(yf + e); bb[q] = *(const f32x4*)(yb + e); uw[q] = *(const u32x2*)(ut + e); }
#pragma unroll
            for (int q = 0; q < 8; ++q) { const int idx = t2 + 128 * (it + q), c4 = (idx & 3) * 4, nn = (idx >> 2) & 31, ii = idx >> 7;
                const size_t tok = (size_t)b * 2048 + 64 * nn + ii;
                const float y0 = a[q][0] + bb[q][0] + d4[0] * bf_lo(uw[q].x), y1 = a[q][1] + bb[q][1] + d4[1] * bf_hi(uw[q].x), y2 = a[q][2] + bb[q][2] + d4[2] * bf_lo(uw[q].y), y3 = a[q][3] + bb[q][3] + d4[3] * bf_hi(uw[q].y);
                u32x2 w; w.x = pk_bf16(gelu_tanh(y0), gelu_tanh(y1)); w.y = pk_bf16(gelu_tanh(y2), gelu_tanh(y3));
                *(u32x2*)(ypre + tok * 384 + g * 16 + c4) = w; }
        }
    }
}

DI void attn_item(const Params& p, LAS unsigned char* lds, int l, int item) {
    const int tid = otid(), wid = tid >> 6, lane = tid & 63, n = lane & 31, hh = lane >> 5;
    const int b = item >> 5, blk = (item >> 1) & 15, kvh = item & 1;
    const bf16_t* z = (const bf16_t*)(p.ws + O_Z);
    bf16_t* ycat = (bf16_t*)(p.ws + O_YCAT);
    constexpr int KROW = 144, VROW = 784, VOFF = 384 * KROW;
    __syncthreads();
    for (int c = tid; c < 3072; c += NTHREADS) {
        const int j = c >> 3, dc = c & 7, pos = blk * 128 - 128 + j;
        u32x4 kv = {0u, 0u, 0u, 0u};
        if (pos >= 0 && pos < 2048) kv = *(const u32x4*)(z + ((size_t)b * 2048 + pos) * 1024 + 768 + kvh * 64 + dc * 8);
        *(LAS u32x4*)(lds + j * KROW + dc * 16) = kv;
    }
    for (int c = tid; c < 3072; c += NTHREADS) {
        const int j = c % 384, dc = c / 384, pos = blk * 128 - 128 + j;
        u32x4 vv = {0u, 0u, 0u, 0u};
        if (pos >= 0 && pos < 2048) vv = *(const u32x4*)(z + ((size_t)b * 2048 + pos) * 1024 + 896 + kvh * 64 + dc * 8);
        LAS bf16_t* vt = (LAS bf16_t*)(lds + VOFF + (dc * 8) * VROW) + j;
        vt[0 * (VROW / 2)] = (bf16_t)(vv.x & 0xffff); vt[1 * (VROW / 2)] = (bf16_t)(vv.x >> 16);
        vt[2 * (VROW / 2)] = (bf16_t)(vv.y & 0xffff); vt[3 * (VROW / 2)] = (bf16_t)(vv.y >> 16);
        vt[4 * (VROW / 2)] = (bf16_t)(vv.z & 0xffff); vt[5 * (VROW / 2)] = (bf16_t)(vv.z >> 16);
        vt[6 * (VROW / 2)] = (bf16_t)(vv.w & 0xffff); vt[7 * (VROW / 2)] = (bf16_t)(vv.w >> 16);
    }
    __syncthreads();
    for (int task = wid; task < 12; task += 8) {
        const int head = kvh * 3 + (task >> 2), qt = task & 3;
        const float slope2 = exp2f(-8.0f * (float)(head + 1) / 6.0f) * 1.442695041f;
        const float sink2 = p.in[I_SINK][l * 6 + head] * 1.442695041f;
        const int qi = 32 * qt + n;
        const size_t tok = (size_t)b * 2048 + blk * 128 + qi;
        bf16x8 qop[4];
#pragma unroll
        for (int s = 0; s < 4; ++s) qop[s] = *(const bf16x8*)(z + tok * 1024 + 384 + head * 64 + 16 * s + 8 * hh);
        f32x16 o0, o1;
#pragma unroll
        for (int i = 0; i < 16; ++i) { o0[i] = 0.f; o1[i] = 0.f; }
        float mrun = sink2, lrun = 0.f;
        float dbase[16];
#pragma unroll
        for (int r = 0; r < 16; ++r) dbase[r] = (float)(128 + n - ((r & 3) + 8 * (r >> 2) + 4 * hh));
        const bool edge_blk = (blk == 0) || (blk == 15);
        for (int kt = qt; kt < qt + 9; ++kt) {
            f32x16 sacc;
#pragma unroll
            for (int i = 0; i < 16; ++i) sacc[i] = 0.f;
#pragma unroll
            for (int s = 0; s < 4; ++s) { const bf16x8 kop = *(const LAS bf16x8*)(lds + (kt * 32 + n) * KROW + (16 * s + 8 * hh) * 2); sacc = MFMA32(kop, qop[s], sacc); }
            const int dk = kt - qt;
            const float off = 32.0f * (float)dk;
            float mx = -1e30f;
            if (dk == 0 || dk == 8 || edge_blk) {
#pragma unroll
                for (int r = 0; r < 16; ++r) {
                    const int j = kt * 32 + (r & 3) + 8 * (r >> 2) + 4 * hh, pos = blk * 128 - 128 + j;
                    const float d = dbase[r] - off;
                    const bool valid = fabsf(d) <= 128.0f && pos >= 0 && pos < 2048;
                    const float sc = valid ? sacc[r] * 0.1803368801f - slope2 * fabsf(d) : -1e30f;
                    sacc[r] = sc; mx = fmaxf(mx, sc);
                }
            } else {
#pragma unroll
                for (int r = 0; r < 16; ++r) { const float sc = sacc[r] * 0.1803368801f - slope2 * fabsf(dbase[r] - off); sacc[r] = sc; mx = fmaxf(mx, sc); }
            }
            mx = fmaxf(mx, bperm(mx, lane ^ 32));
            const float mnew = fmaxf(mrun, mx);
            if (__builtin_amdgcn_ballot_w64(mnew != mrun) != 0ull) {
                const float alpha = __builtin_amdgcn_exp2f(mrun - mnew);
                lrun *= alpha; o0 *= alpha; o1 *= alpha; mrun = mnew;
            }
            float ls = 0.f;
#pragma unroll
            for (int r = 0; r < 16; ++r) { const float pv = __builtin_amdgcn_exp2f(sacc[r] - mrun); sacc[r] = pv; ls += pv; }
            lrun += ls;
#pragma unroll
            for (int s = 0; s < 2; ++s) {
                const bf16x8 pb = pack8(sacc[8 * s], sacc[8 * s + 1], sacc[8 * s + 2], sacc[8 * s + 3], sacc[8 * s + 4], sacc[8 * s + 5], sacc[8 * s + 6], sacc[8 * s + 7]);
#pragma unroll
                for (int dt = 0; dt < 2; ++dt) {
                    const LAS unsigned char* vp = lds + VOFF + (dt * 32 + n) * VROW + (kt * 32 + 16 * s + 4 * hh) * 2;
                    const s16x4 lo = *(const LAS s16x4*)vp, hi = *(const LAS s16x4*)(vp + 16);
                    const bf16x8 vop = __builtin_shufflevector(lo, hi, 0, 1, 2, 3, 4, 5, 6, 7);
                    if (dt == 0) o0 = MFMA32(vop, pb, o0); else o1 = MFMA32(vop, pb, o1);
                }
            }
        }
        const float ltot = lrun + bperm(lrun, lane ^ 32);
        const float inv = 1.0f / (ltot + __builtin_amdgcn_exp2f(sink2 - mrun));
        bf16_t* op = ycat + tok * 1024 + 640 + head * 64 + 4 * hh;
#pragma unroll
        for (int q = 0; q < 4; ++q) {
            u32x2 w0; w0.x = pk_bf16(o0[4 * q] * inv, o0[4 * q + 1] * inv); w0.y = pk_bf16(o0[4 * q + 2] * inv, o0[4 * q + 3] * inv);
            u32x2 w1; w1.x = pk_bf16(o1[4 * q] * inv, o1[4 * q + 1] * inv); w1.y = pk_bf16(o1[4 * q + 2] * inv, o1[4 * q + 3] * inv);
            *(u32x2*)(op + 8 * q) = w0; *(u32x2*)(op + 32 + 8 * q) = w1;
        }
    }
}

#define XB_TMO      128
#define XB_XCNT(j)  (256  + 64 * (j))
#define XB_XSUB(j)  (1280 + 64 * (j))
#define XB_XGEN(j)  (2304 + 64 * (j))
#define XB_TOP      3328
#define XB_TOPGEN   3392
#define XB_SPIN_CAP (1u << 20)
DI unsigned xb_ld(unsigned* p) { return __hip_atomic_load(p, __ATOMIC_RELAXED, __HIP_MEMORY_SCOPE_AGENT); }
DI unsigned xb_add(unsigned* p, unsigned v) { return __hip_atomic_fetch_add(p, v, __ATOMIC_RELAXED, __HIP_MEMORY_SCOPE_AGENT); }
DI unsigned xb_xcc_id() { return (unsigned)__builtin_amdgcn_s_getreg((3 << 11) | 20) & 0xFu; }
#define XB_SPIN(cond, bar) do { unsigned _sp = 0; while (cond) { __builtin_amdgcn_s_sleep(1); \
    if ((++_sp & 255u) == 0u) { if (xb_ld(&(bar)[XB_TMO])) break; if (_sp > XB_SPIN_CAP) { atomicAdd(&(bar)[XB_TMO], 1u); break; } } } } while (0)
DI void xcd_barrier_complete(unsigned* bar, unsigned x, unsigned& nloc, unsigned& nx) {
    const unsigned G = gridDim.x;
    unsigned sum, cnt, mine, sp = 0u;
    for (;;) {
        sum = 0u; cnt = 0u; mine = 0u;
#pragma unroll
        for (unsigned j = 0; j < 16; ++j) { const unsigned c = xb_ld(&bar[XB_XCNT(j)]); sum += c; cnt += (c > 0u) ? 1u : 0u; mine = (j == x) ? c : mine; }
        if (sum == G) break;
        __builtin_amdgcn_s_sleep(1);
        if ((++sp & 255u) == 0u) { if (xb_ld(&bar[XB_TMO])) break; if (sp > XB_SPIN_CAP) { atomicAdd(&bar[XB_TMO], 1u); break; } }
    }
    nloc = mine > 0u ? mine : 1u; nx = cnt > 0u ? cnt : 1u;
}
DI void xcd_barrier(unsigned* bar, volatile LAS unsigned* st) {
    asm volatile("s_waitcnt vmcnt(0)" ::: "memory");
    __syncthreads();
    if (otid() == 0) {
        __builtin_amdgcn_s_waitcnt(0);
        const unsigned x = xb_xcc_id();
        unsigned nloc = st[0], nx = st[1];
        if (nloc == 0u) { xcd_barrier_complete(bar, x, nloc, nx); st[0] = nloc; st[1] = nx; }
        const unsigned old = xb_add(&bar[XB_XSUB(x)], 1u);
        const unsigned gen = old / nloc;
        if (old + 1u == (gen + 1u) * nloc) {
            __builtin_amdgcn_fence(__ATOMIC_RELEASE, "agent");
            asm volatile("s_waitcnt vmcnt(0)" ::: "memory");
            const unsigned og = xb_add(&bar[XB_TOP], 1u);
            const unsigned tg = og / nx;
            if (og + 1u == (tg + 1u) * nx) xb_add(&bar[XB_TOPGEN], 1u);
            else XB_SPIN(xb_ld(&bar[XB_TOPGEN]) == tg, bar);
            __builtin_amdgcn_fence(__ATOMIC_ACQUIRE, "agent");
            xb_add(&bar[XB_XGEN(x)], 1u);
            asm volatile("s_waitcnt vmcnt(0)" ::: "memory");
        } else {
            XB_SPIN(xb_ld(&bar[XB_XGEN(x)]) == gen, bar);
            __builtin_amdgcn_fence(__ATOMIC_ACQUIRE, "agent");
            asm volatile("s_waitcnt vmcnt(0)" ::: "memory");
        }
    }
    __syncthreads();
}
#define EN(k) (((PHASE_EN) >> (k)) & 1u)
constexpr int NPHASE = 2 + 9 * NL;
template <unsigned PHASE_EN> __global__ void __launch_bounds__(NTHREADS, 2) fwd_megakernel(Params p_arg) {
    extern __shared__ __attribute__((aligned(16))) unsigned char lds_raw[];
    LAS unsigned char* lds = (LAS unsigned char*)lds_raw;
    cg::grid_group grid = cg::this_grid();
    const int ph_lo = p_arg.ph_lo, ph_hi = p_arg.ph_hi;
    volatile LAS unsigned* xst = (volatile LAS unsigned*)(lds + LDS_BYTES - 32);
    if (threadIdx.x == 0) { xst[0] = 0u; xst[1] = 0u; (void)xb_add((unsigned*)(p_arg.ws + O_CTR + 1024) + XB_XCNT(xb_xcc_id()), 1u); }
    __syncthreads();
    for (int ph = ph_lo; ph < ph_hi; ++ph) {
#if defined(__HIP_DEVICE_COMPILE__)
        const __attribute__((address_space(4))) Params* pp = (const __attribute__((address_space(4))) Params*)__builtin_amdgcn_kernarg_segment_ptr();
        asm volatile("" : "+s"(pp));
        const Params p = *pp;
#else
        const Params p = p_arg;
#endif
        unsigned char* ws = p.ws;
        const float* mod = (const float*)(ws + O_MOD);
        if (ph == 0) { if (EN(0)) phase_prep(p, lds); }
        else if (ph == 1) {
            if (EN(1)) phase_rows<false>(p.in[I_X], nullptr, nullptr, nullptr, nullptr, nullptr, nullptr, 0, nullptr, false, true, mod, 0, 1024, p.in[I_GPREMIX], (bf16_t*)(ws + O_H));
        } else {
            const int l = (ph - 2) / 9, sp = (ph - 2) % 9;
            unsigned char* wl = ws + l * LAYER_W;
            const float* modl = mod + (size_t)l * 16 * 6144;
            if (sp == 0) {
                SchedInproj S; S.bid = obid(); S.h = (const char*)(ws + O_H); S.win = (const char*)(wl + O_WIN); S.wpq = (const char*)(wl + O_WPQ); S.z = (char*)(ws + O_Z); S.pqt = (char*)(ws + O_PQT);
                S.m1.init(128, 4); S.m2.init(2, 128);
                EpiInproj E; E.ut = (bf16_t*)(ws + O_UT); if (EN(2)) gemm_phase(lds, 1024, 1024, 1024, 1 << 30, 0, S, E);
            } else if (sp == 1) {
                unsigned* ctr = (unsigned*)(ws + O_CTR) + l;
                LAS int* sitem = (LAS int*)(lds + LDS_BYTES - 16);
                for (;;) {
                    __syncthreads();
                    if (otid() == 0) *sitem = (int)atomicAdd(ctr, 1u);
                    __syncthreads();
                    const int qitem = *sitem;
                    if (qitem >= 128 + 96 + 512) break;
                    const int item = qitem < 96 ? qitem + 128 : (qitem < 224 ? qitem - 96 : qitem);
                    if (item < 128) {
                        const int bb = item >> 3, which = (item >> 2) & 1, jt = item & 3;
                        SchedOne S; S.u0.A = (const char*)(ws + O_DFT) + (size_t)(which * 1024 + jt * 256) * 2048 * 2; S.u0.B = (const char*)(ws + O_PQT) + ((size_t)which * 256 * MTOK + (size_t)bb * 2048) * 2;
                        S.u0.C = (char*)(ws + O_AB) + ((size_t)((which * 16 + bb) * 1024 + jt * 256) * 256) * 4; S.u0.ldc = 256; S.u0.pm = jt; S.u0.pn = bb; S.u0.kind = 1;
                        EpiF32 E; if (EN(3)) gemm_phase(lds, 2048, 2048, MTOK, 1 << 30, 0, S, E);
                    } else if (item < 224) { if (EN(4)) ssm_item(p, lds, l, item - 128); }
                    else { if (EN(5)) attn_item(p, lds, l, item - 224); }
                }
            } else if (sp == 2) {
                {
                    const float* ab = (const float*)(ws + O_AB); bf16_t* yc = (bf16_t*)(ws + O_YCAT);
                    const int gt_ = obid() * NTHREADS + otid();
                    const int gstride = (int)gridDim.x * NTHREADS;
                    for (int idx0 = gt_; idx0 < 16 * 1024 * 64; idx0 += 8 * gstride) {
                        f32x4 av[8], bv[8];
#pragma unroll
                        for (int q = 0; q < 8; ++q) { const int idx = idx0 + q * gstride; const bool ok = idx < 16 * 1024 * 64;
                            const int n4 = (idx & 63) * 4, jj = (idx >> 6) & 1023, bb = ok ? idx >> 16 : 0;
                            av[q] = *(const f32x4*)(ab + ((size_t)(bb * 1024 + jj) * 256 + n4)); bv[q] = *(const f32x4*)(ab + ((size_t)((16 + bb) * 1024 + jj) * 256 + n4)); }
#pragma unroll
                        for (int q = 0; q < 8; ++q) { const int idx = idx0 + q * gstride;
                            if (idx < 16 * 1024 * 64) {
                                const int n4 = (idx & 63) * 4, jj = (idx >> 6) & 1023, bb = idx >> 16, j = jj + 1;
                                const f32x4 a = av[q], b4 = bv[q];
                                u32x2 lo, hi; lo.x = pk_bf16(a[0] - b4[0], a[1] - b4[1]); lo.y = pk_bf16(a[2] - b4[2], a[3] - b4[3]);
                                hi.x = pk_bf16(a[0] + b4[0], a[1] + b4[1]); hi.y = pk_bf16(a[2] + b4[2], a[3] + b4[3]);
                                *(u32x2*)(yc + ((size_t)(bb * 2048 + j) * 1024 + 384 + n4)) = lo;
                                *(u32x2*)(yc + ((size_t)(bb * 2048 + 2048 - j) * 1024 + 384 + n4)) = hi; } }
                    }
                    const bf16_t* pq = (const bf16_t*)(ws + O_PQT);
                    const int lane_ = otid() & 63;
                    for (int w = gt_ >> 6; w < 16 * 256; w += (int)gridDim.x * 8) {
                        const int bb = w >> 8, n = w & 255;
                        const bf16_t* src = pq + (size_t)n * MTOK + (size_t)bb * 2048 + lane_ * 32;
                        float sum = 0.f;
#pragma unroll
                        for (int q = 0; q < 4; ++q) { const u32x4 v = *(const u32x4*)(src + q * 8);
                            sum += (bf_lo(v.x) + bf_hi(v.x)) + (bf_lo(v.y) + bf_hi(v.y)) + (bf_lo(v.z) + bf_hi(v.z)) + (bf_lo(v.w) + bf_hi(v.w)); }
                        sum = wave_sum(sum, lane_);
                        if (lane_ == 0) yc[(size_t)(bb * 2048) * 1024 + 384 + n] = f2bf(sum * 0.02209708691f);
                    }
                }
                SchedPlain S; S.bid = obid(); S.A = (const char*)(ws + O_YPRE); S.B = (const char*)(wl + O_WGLU); S.K = 384; S.total = 256; S.tm.init(128, 2);
                EpiGlu E; E.ypre = (const bf16_t*)(ws + O_YPRE); E.ycat = (bf16_t*)(ws + O_YCAT);
                if (EN(6)) gemm_phase(lds, 384, 384, 384, 1 << 30, 0, S, E);
            } else if (sp == 3) {
                SchedPlain S; S.bid = obid(); S.A = (const char*)(ws + O_YCAT); S.B = (const char*)(wl + O_WOUT); S.K = 1024; S.total = 512; S.tm.init(128, 4);
                EpiY E; E.y = (bf16_t*)(ws + O_Y); E.rss = (float*)(ws + O_RSS);
                if (EN(7)) gemm_phase(lds, 1024, 1024, 1024, 1 << 30, 0, S, E);
            } else if (sp == 4) {
                if (l == 0) phase_rows<false>(p.in[I_X], nullptr, nullptr, (bf16_t*)(ws + O_XB), (const bf16_t*)(ws + O_Y), (const float*)(ws + O_RSS), modl, 2048, p.in[I_GPOSTMIX] + l * 1024, true,
                           true, modl, 3072, 4096, p.in[I_GPREFFN] + l * 1024, (bf16_t*)(ws + O_H));
                else phase_rows<true>(nullptr, (const bf16_t*)(ws + O_XB), nullptr, (bf16_t*)(ws + O_XB), (const bf16_t*)(ws + O_Y), (const float*)(ws + O_RSS), modl, 2048, p.in[I_GPOSTMIX] + l * 1024, true,
                           true, modl, 3072, 4096, p.in[I_GPREFFN] + l * 1024, (bf16_t*)(ws + O_H));
            } else if (sp == 5) {
                SchedPlain S; S.bid = obid(); S.A = (const char*)(ws + O_H); S.B = (const char*)(wl + O_WUP); S.K = 1024; S.total = 128 * 22; S.tm.init(128, 22);
                EpiUp E; E.act = (bf16_t*)(ws + O_ACT); E.edge = (bf16_t*)(ws + O_EDGE); E.cw = p.in[I_CONVW] + (size_t)l * 3 * 5632; E.cb = p.in[I_CONVB] + (size_t)l * 5632;
                if (EN(8)) gemm_phase(lds, 1024, 1024, 1024, 1 << 30, 0, S, E);
            } else if (sp == 6) { if (EN(9)) {
                const bf16_t* edge = (const bf16_t*)(ws + O_EDGE); bf16_t* act = (bf16_t*)(ws + O_ACT);
                const float* cw = p.in[I_CONVW] + (size_t)l * 3 * 5632; const float* cb = p.in[I_CONVB] + (size_t)l * 5632;
                for (int idx = obid() * NTHREADS + otid(); idx < 512 * 2 * 704; idx += gridDim.x * NTHREADS) {
                    const int c4 = (idx % 704) * 4, which = (idx / 704) & 1, seg = idx / 1408;
                    const int t = seg * 64 + (which ? 63 : 0);
                    const bf16_t* ec = edge + (size_t)(seg * 4 + (which ? 3 : 0)) * 2 * DFF;
                    const bf16_t* ep = which ? edge + (size_t)(seg * 4 + 2) * 2 * DFF : ((seg & 31) == 0 ? nullptr : edge + (size_t)((seg - 1) * 4 + 3) * 2 * DFF);
                    const bf16_t* en = which ? ((seg & 31) == 31 ? nullptr : edge + (size_t)((seg + 1) * 4 + 0) * 2 * DFF) : edge + (size_t)(seg * 4 + 1) * 2 * DFF;
                    const u32x2 z2 = {0u, 0u};
                    const u32x2 gpw = ep ? *(const u32x2*)(ep + c4) : z2, gcw = *(const u32x2*)(ec + c4), gnw = en ? *(const u32x2*)(en + c4) : z2;
                    const u32x2 vpw = ep ? *(const u32x2*)(ep + DFF + c4) : z2, vcw = *(const u32x2*)(ec + DFF + c4), vnw = en ? *(const u32x2*)(en + DFF + c4) : z2;
                    const f32x4 wg0 = *(const f32x4*)(cw + c4), wg1 = *(const f32x4*)(cw + 5632 + c4), wg2 = *(const f32x4*)(cw + 2 * 5632 + c4), bg = *(const f32x4*)(cb + c4);
                    const f32x4 wv0 = *(const f32x4*)(cw + 2816 + c4), wv1 = *(const f32x4*)(cw + 5632 + 2816 + c4), wv2 = *(const f32x4*)(cw + 2 * 5632 + 2816 + c4), bv = *(const f32x4*)(cb + 2816 + c4);
                    const f32x4 gp = {bf_lo(gpw.x), bf_hi(gpw.x), bf_lo(gpw.y), bf_hi(gpw.y)}, gc = {bf_lo(gcw.x), bf_hi(gcw.x), bf_lo(gcw.y), bf_hi(gcw.y)}, gn = {bf_lo(gnw.x), bf_hi(gnw.x), bf_lo(gnw.y), bf_hi(gnw.y)};
                    const f32x4 vp = {bf_lo(vpw.x), bf_hi(vpw.x), bf_lo(vpw.y), bf_hi(vpw.y)}, vc = {bf_lo(vcw.x), bf_hi(vcw.x), bf_lo(vcw.y), bf_hi(vcw.y)}, vn = {bf_lo(vnw.x), bf_hi(vnw.x), bf_lo(vnw.y), bf_hi(vnw.y)};
                    const f32x4 ug = wg0 * gp + wg1 * gc + wg2 * gn + bg, uv = wv0 * vp + wv1 * vc + wv2 * vn + bv;
                    float o[4];
#pragma unroll
                    for (int j = 0; j < 4; ++j) o[j] = gelu_tanh(ug[j]) * uv[j];
                    u32x2 w; w.x = pk_bf16(o[0], o[1]); w.y = pk_bf16(o[2], o[3]);
                    *(u32x2*)(act + (size_t)t * DFF + c4) = w;
                } }
            } else if (sp == 7) {
                SchedPlain S; S.bid = obid(); S.A = (const char*)(ws + O_ACT); S.B = (const char*)(wl + O_WDN); S.K = 2816; S.total = 512; S.tm.init(128, 4);
                EpiY E; E.y = (bf16_t*)(ws + O_Y); E.rss = (float*)(ws + O_RSS);
                if (EN(10)) gemm_phase(lds, 2816, 2816, 2816, 1 << 30, 0, S, E);
            } else {
                const bool has_next = (l + 1 < NL);
                const float* modn = mod + (size_t)(l + 1) * 16 * 6144;
                phase_rows<true>(nullptr, (const bf16_t*)(ws + O_XB), p.out, has_next ? (bf16_t*)(ws + O_XB) : nullptr, (const bf16_t*)(ws + O_Y), (const float*)(ws + O_RSS), modl, 5120, p.in[I_GPOSTFFN] + l * 1024, true,
                           has_next, modn, 0, 1024, p.in[I_GPREMIX] + (has_next ? (l + 1) * 1024 : 0), (bf16_t*)(ws + O_H));
            }
        }
        if (ph + 1 < ph_hi) { if (ph_hi < 0) grid.sync();   xcd_barrier((unsigned*)(ws + O_CTR + 1024), xst); }
    }
}

constexpr unsigned ALL_KINDS = 0x7ffu;
extern "C" void kernel_launch(void* const* d_in, const int* in_sizes, int n_in, void* d_out, int out_size, void* d_ws, size_t ws_size, hipStream_t stream) {
    static int grid_blocks = 0;
    if (!grid_blocks) {
        int dev = 0, cus = 0, per_cu = 0;
        (void)hipGetDevice(&dev);
        (void)hipDeviceGetAttribute(&cus, hipDeviceAttributeMultiprocessorCount, dev);
        (void)hipFuncSetAttribute((const void*)fwd_megakernel<ALL_KINDS>, hipFuncAttributeMaxDynamicSharedMemorySize, LDS_BYTES);
        (void)hipOccupancyMaxActiveBlocksPerMultiprocessor(&per_cu, fwd_megakernel<ALL_KINDS>, NTHREADS, LDS_BYTES);
        if (per_cu < 1) per_cu = 1;
        grid_blocks = cus * per_cu;
        if (grid_blocks > 256) grid_blocks = 256;
        if (grid_blocks < 8) grid_blocks = 8;
    }
    Params p{};
    for (int i = 0; i < 25; ++i) p.in[i] = (const float*)d_in[i];
    p.out = (float*)d_out; p.ws = (unsigned char*)d_ws; p.ph_lo = 0; p.ph_hi = NPHASE;
    (void)hipMemsetAsync((unsigned char*)d_ws + O_CTR, 0, 16384, stream);
    void* args[] = {&p};
    hipError_t e = hipLaunchCooperativeKernel((const void*)fwd_megakernel<ALL_KINDS>, dim3(grid_blocks), dim3(NTHREADS), args, LDS_BYTES, stream);
    if (e != hipSuccess) fprintf(stderr, "cooperative launch failed: %s (grid %d)\n", hipGetErrorString(e), grid_blocks);
}
```
